# Optimizing an MI355X kernel written in HIP

```python
import jax, jax.numpy as jnp
from jax import lax
import numpy as np

D_MODEL = 4096
BATCH = 1
SEQ = 16384
DEPTH = 1
DEC_BATCH = 2
DEC_SEQ = 4096
PAST_LEN = 128

GRID_W = 64
N_MEM = 256
NA_HEADS = 16
NA_HEAD_DIM = 128
NA_WIDTH = NA_HEADS * NA_HEAD_DIM
NA_MAX_KH = 8
NA_KW = 16
POOL_WINDOWS = (2, 4, 8, 16)
POOL_GROUPS = 4
POOL_GROUP_DIM = 256
POOL_WIDTH = POOL_GROUPS * POOL_GROUP_DIM
MEM_HEADS = 4
MEM_HEAD_DIM = 256
MEM_WIDTH = MEM_HEADS * MEM_HEAD_DIM
N_BRANCH = 3
IN_WIDTH = 3 * NA_WIDTH + POOL_WIDTH + MEM_WIDTH + N_BRANCH * D_MODEL
D_FF = 11008
RMS_EPS = 1e-6

kernel_name = "hybrid_natten_pool_memxattn_macaron_encoder"


def _rmsnorm(x, g):
    xf = x.astype(jnp.float32)
    y = xf * lax.rsqrt(jnp.mean(xf * xf, axis=-1, keepdims=True) + RMS_EPS)
    return (y * g.astype(jnp.float32)).astype(x.dtype)


def _swiglu(h, w_gate, w_up, w_down):
    return (jax.nn.silu(h @ w_gate) * (h @ w_up)) @ w_down


def _neighbourhood_attention(q, k, v, rpb):
    b, L, h, dh = q.shape
    rows = L // GRID_W
    kh = min(NA_MAX_KH, rows)
    n_keys = kh * NA_KW
    cols = jnp.arange(GRID_W)
    col_start = jnp.clip(cols - NA_KW // 2, 0, GRID_W - NA_KW)
    col_idx = col_start[:, None] + jnp.arange(NA_KW)[None, :]
    col_off = col_idx - cols[:, None] + (NA_KW - 1)
    scale = dh ** -0.5
    q_rows = q.reshape(b, rows, GRID_W, h, dh)

    def one_row(r):
        row_start = jnp.clip(r - kh // 2, 0, rows - kh)
        row_ids = row_start + jnp.arange(kh)
        key_idx = (row_ids[None, :, None] * GRID_W + col_idx[:, None, :]).reshape(GRID_W, n_keys)
        row_off = row_ids - r + (NA_MAX_KH - 1)
        bias = rpb[:, row_off[None, :, None], col_off[:, None, :]].reshape(h, GRID_W, n_keys)
        k_g = k[:, key_idx]
        v_g = v[:, key_idx]
        q_r = lax.dynamic_index_in_dim(q_rows, r, axis=1, keepdims=False)
        s = jnp.einsum('bchd,bckhd->bhck', q_r, k_g).astype(jnp.float32) * scale
        s = s + bias.astype(jnp.float32)[None]
        p = jax.nn.softmax(s, axis=-1).astype(v.dtype)
        return jnp.einsum('bhck,bckhd->bchd', p, v_g)

    o = lax.map(one_row, jnp.arange(rows))
    return jnp.moveaxis(o, 0, 1).reshape(b, L, h * dh)


def _pool_mixer(u, w_pool, pool_scale):
    b, L, _ = u.shape
    ug = u.astype(jnp.float32).reshape(b, L, POOL_GROUPS, POOL_GROUP_DIM)
    csum = jnp.concatenate(
        [jnp.zeros((b, 1, POOL_GROUPS, POOL_GROUP_DIM), jnp.float32), jnp.cumsum(ug, axis=1)], axis=1)
    t = jnp.arange(L)
    outs = []
    for g, w in enumerate(POOL_WINDOWS):
        lo = jnp.clip(t - w // 2, 0, L)
        hi = jnp.clip(t + w // 2, 0, L)
        window_sum = csum[:, hi, g] - csum[:, lo, g]
        mean = window_sum / (hi - lo).astype(jnp.float32)[None, :, None]
        outs.append(mean - ug[:, :, g])
    pooled = jnp.stack(outs, axis=2).astype(u.dtype)
    mixed = jnp.einsum('blgc,gcd->blgd', pooled, w_pool).reshape(b, L, POOL_WIDTH)
    return mixed * pool_scale


def _memory_xattn(q_c, mem, g_mem, w_mem_kv):
    b, L, _ = q_c.shape
    kv = (_rmsnorm(mem, g_mem) @ w_mem_kv).reshape(b, mem.shape[1], 2, MEM_HEADS, MEM_HEAD_DIM)
    k, v = kv[:, :, 0], kv[:, :, 1]
    q = q_c.reshape(b, L, MEM_HEADS, MEM_HEAD_DIM)
    s = jnp.einsum('blhd,bmhd->bhlm', q, k).astype(jnp.float32) * (MEM_HEAD_DIM ** -0.5)
    p = jax.nn.softmax(s, axis=-1).astype(v.dtype)
    return jnp.einsum('bhlm,bmhd->blhd', p, v).reshape(b, L, MEM_WIDTH)


def _layer(x, mem,
           g_ffn1_pre, w1_gate, w1_up, w1_down, g_ffn1_post,
           g_mix_pre, w_in, rpb, w_pool, pool_scale, g_mem, w_mem_kv,
           w_a_out, w_b_out, w_c_out, b_gate, w_o, g_mix_post,
           g_ffn2_pre, w2_gate, w2_up, w2_down, g_ffn2_post, g_final):
    b, L, d = x.shape
    x = x + 0.5 * _rmsnorm(_swiglu(_rmsnorm(x, g_ffn1_pre), w1_gate, w1_up, w1_down), g_ffn1_post)
    h = _rmsnorm(x, g_mix_pre)
    z = h @ w_in
    o1 = NA_WIDTH
    o2 = 2 * NA_WIDTH
    o3 = 3 * NA_WIDTH
    o4 = o3 + POOL_WIDTH
    o5 = o4 + MEM_WIDTH
    q_a, k_a, v_a, u_b, q_c, gate_logits = jnp.split(z, [o1, o2, o3, o4, o5], axis=-1)
    hs = (b, L, NA_HEADS, NA_HEAD_DIM)
    y_a = _neighbourhood_attention(q_a.reshape(hs), k_a.reshape(hs), v_a.reshape(hs), rpb) @ w_a_out
    y_b = _pool_mixer(u_b, w_pool, pool_scale) @ w_b_out
    y_c = _memory_xattn(q_c, mem, g_mem, w_mem_kv) @ w_c_out
    gates = jax.nn.sigmoid(gate_logits.reshape(b, L, N_BRANCH, d) + b_gate)
    merged = gates[:, :, 0] * y_a + gates[:, :, 1] * y_b + gates[:, :, 2] * y_c
    x = x + _rmsnorm(merged @ w_o, g_mix_post)
    x = x + 0.5 * _rmsnorm(_swiglu(_rmsnorm(x, g_ffn2_pre), w2_gate, w2_up, w2_down), g_ffn2_post)
    return _rmsnorm(x, g_final)


def setup_inputs(seed: int = 0) -> dict:
    key = jax.random.key(seed)
    ks = iter(jax.random.split(key, 40))
    f32 = jnp.float32

    def nrm(shape, scale):
        return jax.random.normal(next(ks), shape, f32) * scale

    def gain(shape):
        return 1.0 + 0.02 * jax.random.normal(next(ks), shape, f32)

    D = D_MODEL
    L_ = DEPTH
    return {
        "x_prompt": nrm((BATCH, SEQ, D), 1.0),
        "x_sample": nrm((DEC_BATCH, DEC_SEQ, D), 1.0),
        "mem_prompt": nrm((BATCH, N_MEM, D), 1.0),
        "mem_sample": nrm((DEC_BATCH, N_MEM, D), 1.0),
        "g_ffn1_pre": gain((L_, D)),
        "w1_gate": nrm((L_, D, D_FF), D ** -0.5),
        "w1_up": nrm((L_, D, D_FF), D ** -0.5),
        "w1_down": nrm((L_, D_FF, D), D_FF ** -0.5),
        "g_ffn1_post": gain((L_, D)),
        "g_mix_pre": gain((L_, D)),
        "w_in": nrm((L_, D, IN_WIDTH), D ** -0.5),
        "rpb": nrm((L_, NA_HEADS, 2 * NA_MAX_KH - 1, 2 * NA_KW - 1), 0.1),
        "w_pool": nrm((L_, POOL_GROUPS, POOL_GROUP_DIM, POOL_GROUP_DIM), POOL_GROUP_DIM ** -0.5),
        "pool_scale": gain((L_, POOL_WIDTH)),
        "g_mem": gain((L_, D)),
        "w_mem_kv": nrm((L_, D, 2 * MEM_WIDTH), D ** -0.5),
        "w_a_out": nrm((L_, NA_WIDTH, D), NA_WIDTH ** -0.5),
        "w_b_out": nrm((L_, POOL_WIDTH, D), POOL_WIDTH ** -0.5),
        "w_c_out": nrm((L_, MEM_WIDTH, D), MEM_WIDTH ** -0.5),
        "b_gate": nrm((L_, N_BRANCH, D), 0.01),
        "w_o": nrm((L_, D, D), D ** -0.5),
        "g_mix_post": gain((L_, D)),
        "g_ffn2_pre": gain((L_, D)),
        "w2_gate": nrm((L_, D, D_FF), D ** -0.5),
        "w2_up": nrm((L_, D, D_FF), D ** -0.5),
        "w2_down": nrm((L_, D_FF, D), D_FF ** -0.5),
        "g_ffn2_post": gain((L_, D)),
        "g_final": gain((L_, D)),
    }


def reference(x_prompt, x_sample, mem_prompt, mem_sample,
              g_ffn1_pre, w1_gate, w1_up, w1_down, g_ffn1_post,
              g_mix_pre, w_in, rpb, w_pool, pool_scale, g_mem, w_mem_kv,
              w_a_out, w_b_out, w_c_out, b_gate, w_o, g_mix_post,
              g_ffn2_pre, w2_gate, w2_up, w2_down, g_ffn2_post, g_final):
    y_prompt = x_prompt
    y_sample = x_sample
    for i in range(DEPTH):
        p = [a[i] for a in (g_ffn1_pre, w1_gate, w1_up, w1_down, g_ffn1_post,
                            g_mix_pre, w_in, rpb, w_pool, pool_scale, g_mem, w_mem_kv,
                            w_a_out, w_b_out, w_c_out, b_gate, w_o, g_mix_post,
                            g_ffn2_pre, w2_gate, w2_up, w2_down, g_ffn2_post, g_final)]
        y_prompt = _layer(y_prompt, mem_prompt, *p)
        y_sample = _layer(y_sample, mem_sample, *p)
    return (y_prompt, y_sample)
```

```cpp
#include <hip/hip_runtime.h>
#include <cstdio>
#include <cstdint>

#ifndef PROBE_SEQ
#define PROBE_SEQ 0,1,2,3,4,5,6,7,8,9,10,11,12
#endif
#ifndef MK_N_LAUNCHES
#define MK_N_LAUNCHES 1
#endif

__device__ __forceinline__ int launder_tid() { int t = threadIdx.x; asm volatile("" : "+v"(t)); return t; }
__host__ __device__ __forceinline__ size_t blk_off(int r, int c, int W) { return ((size_t)(r >> 8) * (size_t)(W >> 6) + (size_t)(c >> 6)) * 32768u + (size_t)((r & 255) * 128 + (c & 63) * 2); }
namespace pg8 {
#define PG8_LAS __attribute__((address_space(3)))
typedef unsigned short bf16_t;
typedef short bf16x8 __attribute__((ext_vector_type(8)));
typedef float f32x4 __attribute__((ext_vector_type(4)));
typedef unsigned u32x4 __attribute__((ext_vector_type(4)));
constexpr int BM = 256, BK = 64, HALF = 128, HTB = HALF * BK * 2  , STAGE_BYTES = 8 * HTB, NXCD = 8, WGM = 8;

__host__ __device__ __forceinline__ int lds_byte(int r, int c) { const int st = (r >> 4) * 2 + (c >> 5), rr = r & 15, cc = c & 31, ob = rr * 64 + cc * 2; return st * 1024 + (ob ^ (((ob >> 9) & 1) << 5)); }
__host__ __device__ __forceinline__ void stage_rc(int b, int& R, int& C) { const int st = b / 1024, sb = b % 1024, swz = sb ^ (((sb >> 9) & 1) << 5); R = (st >> 1) * 16 + swz / 64; C = (st & 1) * 32 + (swz % 64) / 2; }
__host__ __device__ __forceinline__ int perm32(int rho) { const int n = rho >> 4, i = rho & 15; return 8 * (i >> 2) + 4 * n + (i & 3); }
__host__ __device__ __forceinline__ int invperm32(int c) { return ((c >> 2) & 1) * 16 + (c >> 3) * 4 + (c & 3); }

struct Unit { int pm, pn; };
struct Gemm { const bf16_t* A; const bf16_t* Bt; int M, N, K, lda, a_pn_bytes; };

struct StaticOrder {
    int nM, nN, nwg, G, c, wgm;
    __host__ __device__ void init(int M, int N, int G_, int c_, int wgm_ = WGM) { nM = M / BM; nN = N / BM; nwg = nM * nN; G = G_; c = c_; wgm = wgm_; }
    __host__ __device__ bool next(int i, Unit& u) const {
        const long L = (long)i * G + c; if (L >= nwg || c < 0) return false;
        int wgid = (int)L; { const int q = nwg / NXCD, r = nwg % NXCD, xcd = wgid % NXCD, off = wgid / NXCD; wgid = (xcd < r ? xcd * (q + 1) : r * (q + 1) + (xcd - r) * q) + off; }
        const int nig = wgm * nN, gid = wgid / nig, fm = gid * wgm, gsz = (nM - fm) < wgm ? (nM - fm) : wgm;
        u.pm = fm + ((wgid % nig) % gsz); u.pn = (wgid % nig) / gsz; return true;
    }
    __device__ __forceinline__ void a_ready(const Unit&) const {}
    __device__ __forceinline__ void done(const Unit&) const {}
};

struct XcdOrder {
    int nN, c, G; StaticOrder fb; bool use;
    __host__ __device__ void init(int M, int N, int G_, int c_, int wgm_ = WGM) { nN = N / BM; c = c_; G = G_; use = (G_ == 256 && M / BM == 96); fb.init(M, N, G_, c_, wgm_); }
    __host__ __device__ bool next(int i, Unit& u) const {
        if (!use) return fb.next(i, u);
        const int x = c & 7, idx = 32 * i + (c >> 3), nA = 8 * nN;
        if (idx < nA) { u.pm = 12 * x + (idx & 7); u.pn = idx >> 3; return true; }
        const int i2 = idx - nA; if (i2 < 4 * nN) { u.pm = 12 * x + 8 + (i2 & 3); u.pn = i2 >> 2; return true; }
        return false;
    }
    __device__ __forceinline__ void a_ready(const Unit&) const {}
    __device__ __forceinline__ void done(const Unit&) const {}
};
__device__ __forceinline__ unsigned cvt_pk_bf16(float lo, float hi) { unsigned r; asm volatile("v_cvt_pk_bf16_f32 %0, %1, %2" : "=v"(r) : "v"(lo), "v"(hi)); return r; }
__device__ __forceinline__ float bf_lo(unsigned w) { return __uint_as_float(w << 16); }
__device__ __forceinline__ float bf_hi(unsigned w) { return __uint_as_float(w & 0xffff0000u); }

struct EpiStore {
    static constexpr bool PERM = false, HAS_MID = false; static constexpr int NSTORE = 16;
    bf16_t* O; int ldc; const float* colscale; float alpha;
    __device__ __forceinline__ void operator()(const f32x4 (&acc)[2][2][4][2], const Unit& u, int wr, int wc, int fr, int fq) const {
        const int row0 = u.pm * BM + wr * 64 + fr, col0 = u.pn * BM + wc * 32 + 8 * fq;
        f32x4 sc[2][2];
#pragma unroll
        for (int bj = 0; bj < 2; ++bj)
#pragma unroll
            for (int n = 0; n < 2; ++n) sc[bj][n] = colscale ? *(const f32x4*)(colscale + col0 + bj * HALF + 4 * n) * alpha : (f32x4){alpha, alpha, alpha, alpha};
#pragma unroll
        for (int ai = 0; ai < 2; ++ai)
#pragma unroll
            for (int m = 0; m < 4; ++m) { bf16_t* rowp = O + (size_t)(row0 + ai * HALF + m * 16) * ldc + col0;
#pragma unroll
                for (int bj = 0; bj < 2; ++bj) { const f32x4 v0 = acc[ai][bj][m][0] * sc[bj][0], v1 = acc[ai][bj][m][1] * sc[bj][1];
                    u32x4 w; w.x = cvt_pk_bf16(v0[0], v0[1]); w.y = cvt_pk_bf16(v0[2], v0[3]); w.z = cvt_pk_bf16(v1[0], v1[1]); w.w = cvt_pk_bf16(v1[2], v1[3]);
                    *(u32x4*)(rowp + bj * HALF) = w; } }
    }
};
struct EpiStoreBlk {
    static constexpr bool PERM = false, HAS_MID = false; static constexpr int NSTORE = 16;
    bf16_t* O; int W, coff; const float* colscale;
    __device__ __forceinline__ void operator()(const f32x4 (&acc)[2][2][4][2], const Unit& u, int wr, int wc, int fr, int fq) const {
        const int row0 = u.pm * BM + wr * 64 + fr, col0 = u.pn * BM + wc * 32 + 8 * fq;
        f32x4 sc[2][2];
#pragma unroll
        for (int bj = 0; bj < 2; ++bj)
#pragma unroll
            for (int n = 0; n < 2; ++n) sc[bj][n] = colscale ? *(const f32x4*)(colscale + col0 + bj * HALF + 4 * n) : (f32x4){1.f, 1.f, 1.f, 1.f};
#pragma unroll
        for (int ai = 0; ai < 2; ++ai)
#pragma unroll
            for (int m = 0; m < 4; ++m)
#pragma unroll
                for (int bj = 0; bj < 2; ++bj) { const f32x4 v0 = acc[ai][bj][m][0] * sc[bj][0], v1 = acc[ai][bj][m][1] * sc[bj][1];
                    u32x4 w; w.x = cvt_pk_bf16(v0[0], v0[1]); w.y = cvt_pk_bf16(v0[2], v0[3]); w.z = cvt_pk_bf16(v1[0], v1[1]); w.w = cvt_pk_bf16(v1[2], v1[3]);
                    *(u32x4*)((char*)O + blk_off(row0 + ai * HALF + m * 16, coff + col0 + bj * HALF, W)) = w; }
    }
};
struct EpiSwiGLU {
    static constexpr bool PERM = false, HAS_MID = false; static constexpr int NSTORE = 8;
    bf16_t* H; int ldc;
    __device__ __forceinline__ void operator()(const f32x4 (&acc)[2][2][4][2], const Unit& u, int wr, int wc, int fr, int fq) const {
        const int row0 = u.pm * BM + wr * 64 + fr, col0 = u.pn * HALF + wc * 32 + 8 * fq;
#pragma unroll
        for (int ai = 0; ai < 2; ++ai)
#pragma unroll
            for (int m = 0; m < 4; ++m) { bf16_t* rowp = (bf16_t*)((char*)H + blk_off(row0 + ai * HALF + m * 16, col0, ldc)); float o[8];
#pragma unroll
                for (int n = 0; n < 2; ++n)
#pragma unroll
                    for (int j = 0; j < 4; ++j) { const float g = acc[ai][0][m][n][j], up = acc[ai][1][m][n][j];
                        const float sg = __builtin_amdgcn_rcpf(1.0f + __builtin_amdgcn_exp2f(-1.44269504089f * g)); o[4 * n + j] = g * sg * up; }
                u32x4 w; w.x = cvt_pk_bf16(o[0], o[1]); w.y = cvt_pk_bf16(o[2], o[3]); w.z = cvt_pk_bf16(o[4], o[5]); w.w = cvt_pk_bf16(o[6], o[7]);
                *(u32x4*)rowp = w; }
    }
};
struct EpiGateE {
    static constexpr bool PERM = false, HAS_MID = false; static constexpr int NSTORE = 16;
    bf16_t* O; int ldc; const float* bias; float alpha;
    __device__ __forceinline__ void operator()(const f32x4 (&acc)[2][2][4][2], const Unit& u, int wr, int wc, int fr, int fq) const {
        const int row0 = u.pm * BM + wr * 64 + fr, col0 = u.pn * BM + wc * 32 + 8 * fq;
        f32x4 bv[2][2];
#pragma unroll
        for (int bj = 0; bj < 2; ++bj)
#pragma unroll
            for (int n = 0; n < 2; ++n) bv[bj][n] = *(const f32x4*)(bias + col0 + bj * HALF + 4 * n);
#pragma unroll
        for (int ai = 0; ai < 2; ++ai)
#pragma unroll
            for (int m = 0; m < 4; ++m) { bf16_t* rowp = O + (size_t)(row0 + ai * HALF + m * 16) * ldc + col0;
#pragma unroll
                for (int bj = 0; bj < 2; ++bj) { float o[8];
#pragma unroll
                    for (int n = 0; n < 2; ++n)
#pragma unroll
                        for (int j = 0; j < 4; ++j) { const float l = fminf(fmaxf(acc[ai][bj][m][n][j] * alpha + bv[bj][n][j], -30.f), 30.f); o[4 * n + j] = 1.0f + __builtin_amdgcn_exp2f(-1.44269504089f * l); }
                    u32x4 w; w.x = cvt_pk_bf16(o[0], o[1]); w.y = cvt_pk_bf16(o[2], o[3]); w.z = cvt_pk_bf16(o[4], o[5]); w.w = cvt_pk_bf16(o[6], o[7]);
                    *(u32x4*)(rowp + bj * HALF) = w; } }
    }
};
struct EpiChain {
    static constexpr bool PERM = false, HAS_MID = true; static constexpr int NSTORE = 16;
    bf16_t* O; int ldc; const bf16_t* G; int ldg; int mid0, mid1;
    __device__ __forceinline__ void mid(f32x4 (&acc)[2][2][4][2], const Unit& u, int wr, int wc, int fr, int fq, int which) const {
        const int row0 = u.pm * BM + wr * 64 + fr, col0 = u.pn * BM + wc * 32 + 8 * fq;
        const bf16_t* gbase = G + (size_t)row0 * ldg + which * 4096 + col0;
#pragma unroll
        for (int bj = 0; bj < 2; ++bj)
#pragma unroll
            for (int ai = 0; ai < 2; ++ai) {
                u32x4 gd[4], gn[4];
#pragma unroll
                for (int m = 0; m < 4; ++m) { const bf16_t* gp = gbase + (size_t)(ai * HALF + m * 16) * ldg + bj * HALF; gd[m] = *(const u32x4*)gp; gn[m] = *(const u32x4*)(gp + 4096); }
#pragma unroll
                for (int m = 0; m < 4; ++m)
#pragma unroll
                    for (int j = 0; j < 4; ++j) { const int n = j >> 1, e = (j & 1) * 2;
                        const float d0 = bf_lo(gd[m][j]), d1 = bf_hi(gd[m][j]), r = __builtin_amdgcn_rcpf(d0 * d1);
                        acc[ai][bj][m][n][e] *= bf_lo(gn[m][j]) * (r * d1); acc[ai][bj][m][n][e + 1] *= bf_hi(gn[m][j]) * (r * d0); }
                asm volatile("" ::: "memory");
            }
    }
    __device__ __forceinline__ void operator()(const f32x4 (&acc)[2][2][4][2], const Unit& u, int wr, int wc, int fr, int fq) const {
        const int row0 = u.pm * BM + wr * 64 + fr, col0 = u.pn * BM + wc * 32 + 8 * fq;
#pragma unroll
        for (int ai = 0; ai < 2; ++ai)
#pragma unroll
            for (int m = 0; m < 4; ++m) { const size_t r = (size_t)(row0 + ai * HALF + m * 16); const bf16_t* gp = G + r * ldg + 2 * 4096 + col0;
#pragma unroll
                for (int bj = 0; bj < 2; ++bj) { const u32x4 gw = *(const u32x4*)(gp + bj * HALF); float o[8];
#pragma unroll
                    for (int j = 0; j < 4; ++j) { const int n = j >> 1, e = (j & 1) * 2;
                        const float d0 = bf_lo(gw[j]), d1 = bf_hi(gw[j]), rr = __builtin_amdgcn_rcpf(d0 * d1);
                        o[2 * j] = (rr * d1) * acc[ai][bj][m][n][e]; o[2 * j + 1] = (rr * d0) * acc[ai][bj][m][n][e + 1]; }
                    u32x4 w; w.x = cvt_pk_bf16(o[0], o[1]); w.y = cvt_pk_bf16(o[2], o[3]); w.z = cvt_pk_bf16(o[4], o[5]); w.w = cvt_pk_bf16(o[6], o[7]);
                    *(u32x4*)((char*)O + blk_off((int)r, col0 + bj * HALF, ldc)) = w; } }
    }
};

typedef int i32x8 __attribute__((ext_vector_type(8)));
typedef int i32x4_t __attribute__((ext_vector_type(4)));
template <bool FP8 = false, class Epi, class Sched>
__device__ __forceinline__ void gemm_phase(PG8_LAS unsigned char* lds, const Gemm g, const Sched& S, const Epi& E) {
    const int tid = launder_tid(), wid = __builtin_amdgcn_readfirstlane(tid >> 6), lane = tid & 63, wr = wid >> 2, wc = wid & 3, fr = lane & 15, fq = lane >> 4;
    const int K = g.K, nt = K / BK;
    unsigned voffA[2], voffB[2];
#pragma unroll
    for (int i = 0; i < 2; ++i) { int R, C; stage_rc(tid * 16 + i * 8192, R, C); const int Rb = Epi::PERM ? ((R & ~31) + perm32(R & 31)) : R;
        voffA[i] = (unsigned)(R * 64 + C) * 2u; voffB[i] = (unsigned)(Rb * 64 + C) * 2u; }
    const size_t kstep = 32768;
    const size_t hstepA = 16384, hstepB = 16384;
    const size_t tstepA = (size_t)g.lda * 512, tstepB = (size_t)K * 512;
    const unsigned ldsw = (unsigned)wid * 1024u;
    const int aoff = lds_byte(wr * 64 + fr, fq * 8), boff = lds_byte(wc * 32 + fr, fq * 8);
    const PG8_LAS unsigned char* ldsB = lds + 4 * HTB + boff;
#define PG8_SA(b, h) (((b) * 2 + (h)) * HTB)
#define PG8_SB(b, h) ((4 + (b) * 2 + (h)) * HTB)
#define PG8_STAGE(bufoff, gbase, voff) do { _Pragma("unroll") for (int _i = 0; _i < 2; ++_i) \
        __builtin_amdgcn_global_load_lds((const unsigned*)((const char*)(gbase) + (voff)[_i]), (PG8_LAS unsigned*)(lds + (bufoff) + ldsw + _i * 8192), 16, 0, 0); } while (0)
#define PG8_LDA(dst, b, h) do { _Pragma("unroll") for (int m = 0; m < 4; ++m) _Pragma("unroll") for (int k = 0; k < 2; ++k) dst[m][k] = *(const PG8_LAS bf16x8*)(lds + PG8_SA(b, h) + aoff + m * 2048 + k * 1024); } while (0)
#define PG8_LDB(dst, b, h) do { _Pragma("unroll") for (int n = 0; n < 2; ++n) _Pragma("unroll") for (int k = 0; k < 2; ++k) dst[n][k] = *(const PG8_LAS bf16x8*)(ldsB + (PG8_SB(b, h) - 4 * HTB) + n * 2048 + k * 1024); } while (0)
#define PG8_CAT(x) __builtin_shufflevector(__builtin_bit_cast(i32x4_t, (x)[0]), __builtin_bit_cast(i32x4_t, (x)[1]), 0, 1, 2, 3, 4, 5, 6, 7)
#define PG8_MMA(ai, bj, At, Bt) do { __builtin_amdgcn_s_setprio(1); _Pragma("unroll") for (int m = 0; m < 4; ++m) _Pragma("unroll") for (int n = 0; n < 2; ++n) { \
        if constexpr (FP8) acc[ai][bj][m][n] = __builtin_amdgcn_mfma_scale_f32_16x16x128_f8f6f4(PG8_CAT(Bt[n]), PG8_CAT(At[m]), acc[ai][bj][m][n], 0, 0, 0, 0, 0, 0); \
        else { _Pragma("unroll") for (int k = 0; k < 2; ++k) acc[ai][bj][m][n] = __builtin_amdgcn_mfma_f32_16x16x32_bf16(Bt[n][k], At[m][k], acc[ai][bj][m][n], 0, 0, 0); } } \
        __builtin_amdgcn_s_setprio(0); } while (0)
#define PG8_WAIT_V(n) asm volatile("s_waitcnt vmcnt(" #n ")" ::: "memory")
#define PG8_WAIT_VN(n) asm volatile("s_waitcnt vmcnt(%0)" :: "n"(n) : "memory")
#define PG8_WAIT_L(n) asm volatile("s_waitcnt lgkmcnt(" #n ")" ::: "memory")
#define PG8_BAR __builtin_amdgcn_s_barrier()
#define PG8_SCHED __builtin_amdgcn_sched_barrier(0)
    Unit cur, nxt; int ui = 0;
    if (!S.next(0, cur)) return;
    f32x4 acc[2][2][4][2];
#pragma unroll
    for (int a = 0; a < 2; ++a)
#pragma unroll
        for (int b = 0; b < 2; ++b)
#pragma unroll
            for (int m = 0; m < 4; ++m)
#pragma unroll
                for (int n = 0; n < 2; ++n) acc[a][b][m][n] = (f32x4){0.f, 0.f, 0.f, 0.f};
    bf16x8 At[4][2], B0[2][2], B1[2][2];
    const char* cA = (const char*)g.A + (size_t)cur.pm * tstepA + (size_t)cur.pn * g.a_pn_bytes; const char* cB = (const char*)g.Bt + (size_t)cur.pn * tstepB;
    S.a_ready(cur);
    PG8_STAGE(PG8_SB(0, 0), cB, voffB); PG8_STAGE(PG8_SB(0, 1), cB + hstepB, voffB); PG8_STAGE(PG8_SA(0, 0), cA, voffA); PG8_STAGE(PG8_SA(0, 1), cA + hstepA, voffA);
    if (wr == 1) PG8_BAR;
    PG8_WAIT_V(2); PG8_BAR;
    PG8_STAGE(PG8_SB(1, 0), cB + kstep, voffB); PG8_STAGE(PG8_SA(1, 0), cA + kstep, voffA); PG8_STAGE(PG8_SB(1, 1), cB + hstepB + kstep, voffB);
    PG8_WAIT_V(6); PG8_BAR;
    for (;;) {
        const bool has_next = S.next(ui + 1, nxt);
        const char* nA = has_next ? (const char*)g.A + (size_t)nxt.pm * tstepA + (size_t)nxt.pn * g.a_pn_bytes : cA; const char* nB = has_next ? (const char*)g.Bt + (size_t)nxt.pn * tstepB : cB;
        for (int t = 0; t < nt; t += 2) {
            const bool last = (t == nt - 2);
            const char* a1 = cA + (size_t)(t + 1) * kstep;
            const char* a2 = last ? nA : cA + (size_t)(t + 2) * kstep; const char* b2 = last ? nB : cB + (size_t)(t + 2) * kstep;
            const char* a3 = a2 + kstep; const char* b3 = b2 + kstep;
            if (last && has_next) S.a_ready(nxt);
            const bool relax = (ui > 0) && (t == 0);
            PG8_LDB(B0, 0, 0); PG8_LDB(B1, 0, 1); PG8_SCHED; PG8_LDA(At, 0, 0); PG8_STAGE(PG8_SA(1, 1), a1 + hstepA, voffA);
            if (relax) PG8_WAIT_VN(8 + Epi::NSTORE); else PG8_WAIT_V(8);
            PG8_WAIT_L(0); PG8_BAR; PG8_MMA(0, 0, At, B0); PG8_MMA(0, 1, At, B1); PG8_BAR; PG8_SCHED;
            PG8_LDA(At, 0, 1); PG8_STAGE(PG8_SB(0, 0), b2, voffB); PG8_STAGE(PG8_SB(0, 1), b2 + hstepB, voffB); PG8_STAGE(PG8_SA(0, 0), a2, voffA);
            if (relax) PG8_WAIT_VN(8 + Epi::NSTORE); else PG8_WAIT_V(8);
            PG8_WAIT_L(0); PG8_BAR; PG8_MMA(1, 0, At, B0); PG8_MMA(1, 1, At, B1); PG8_BAR; PG8_SCHED;
            PG8_LDB(B0, 1, 0); PG8_LDB(B1, 1, 1); PG8_SCHED; PG8_LDA(At, 1, 0); PG8_STAGE(PG8_SA(0, 1), a2 + hstepA, voffA);
            PG8_WAIT_V(8); PG8_WAIT_L(0); PG8_BAR; PG8_MMA(0, 0, At, B0); PG8_MMA(0, 1, At, B1); PG8_BAR; PG8_SCHED;
            PG8_LDA(At, 1, 1); PG8_STAGE(PG8_SB(1, 0), b3, voffB); PG8_STAGE(PG8_SB(1, 1), b3 + hstepB, voffB); PG8_STAGE(PG8_SA(1, 0), a3, voffA);
            PG8_WAIT_V(8); PG8_WAIT_L(0); PG8_BAR; PG8_MMA(1, 0, At, B0); PG8_MMA(1, 1, At, B1); PG8_BAR; PG8_SCHED;
            if constexpr (Epi::HAS_MID) { const int tn = t + 2; if (tn == E.mid0 || tn == E.mid1) { E.mid(acc, cur, wr, wc, fr, fq, tn == E.mid1 ? 1 : 0); PG8_SCHED; } }
        }
        if (wr == 0) PG8_BAR;
        E(acc, cur, wr, wc, fr, fq); S.done(cur);
        if (!has_next) break;
#pragma unroll
        for (int a = 0; a < 2; ++a)
#pragma unroll
            for (int b = 0; b < 2; ++b)
#pragma unroll
                for (int m = 0; m < 4; ++m)
#pragma unroll
                    for (int n = 0; n < 2; ++n) acc[a][b][m][n] = (f32x4){0.f, 0.f, 0.f, 0.f};
        cur = nxt; cA = nA; cB = nB; ++ui;
        if (wr == 1) PG8_BAR;
    }
    PG8_WAIT_V(0);
    PG8_BAR;
#undef PG8_SA
#undef PG8_SB
#undef PG8_STAGE
#undef PG8_LDA
#undef PG8_LDB
#undef PG8_MMA
#undef PG8_CAT
#undef PG8_WAIT_V
#undef PG8_WAIT_VN
#undef PG8_WAIT_L
#undef PG8_BAR
#undef PG8_SCHED
}
}

constexpr int NWAVES = 8;
constexpr int D = 4096, DFF = 11008, NTOK = 24576, NPROMPT = 16384, ZW = 20480;
constexpr int OQ = 0, OKA = 2048, OVA = 4096, OU = 6144, OQC = 7168, OGATE = 8192;
constexpr int NMEMROW = 768, KVW = 2048;
constexpr float RMS_EPS = 1e-6f;
constexpr int N_PHASES = 13;

constexpr size_t MiB = 1u << 20;
constexpr size_t WS_CTL = 0, CTL_ZERO_BYTES = 1 * MiB;
constexpr size_t WS_MEMN = 1 * MiB;
constexpr size_t WS_KVMEM = 7 * MiB;
constexpr size_t WS_WPOOL = 10 * MiB;
constexpr size_t WS_WMEMKV = 11 * MiB;
constexpr size_t WS_WA = 27 * MiB;
constexpr size_t WS_WB = 43 * MiB;
constexpr size_t WS_WC = 51 * MiB;
constexpr size_t WS_WO = 59 * MiB;
constexpr size_t WS_WIN = 91 * MiB;
constexpr size_t WS_WGU = 251 * MiB;
constexpr size_t WS_WD = 423 * MiB;
constexpr size_t WS_POOLED = 251 * MiB;
constexpr size_t WS_H8 = 299 * MiB;
constexpr size_t WS_W8G = 395 * MiB;
constexpr size_t WS_H = 509 * MiB;
constexpr size_t WS_T = 701 * MiB;
constexpr size_t WS_ABUF = 701 * MiB, WS_BBUF = 797 * MiB, WS_CBUF = 845 * MiB;
constexpr size_t WS_BIG = 893 * MiB;
constexpr size_t WS_END = 1853 * MiB;
constexpr int CW_TMO = 0, CW_BAR = 4096;

constexpr int RING_BYTES = 131072, LDSCTL_OFF = RING_BYTES, MISC_OFF = LDSCTL_OFF + 320, LDS_BYTES = 147456;

#define GAS __attribute__((address_space(1)))
#define LAS __attribute__((address_space(3)))
typedef unsigned short bf16;
typedef unsigned v4u __attribute__((ext_vector_type(4)));
typedef unsigned v2u __attribute__((ext_vector_type(2)));
typedef float f32x4 __attribute__((ext_vector_type(4)));
typedef short bf16x8 __attribute__((ext_vector_type(8)));
typedef short s16x4 __attribute__((ext_vector_type(4)));
typedef GAS unsigned gu32;
#define RLX_AGENT __ATOMIC_RELAXED, __HIP_MEMORY_SCOPE_AGENT
#define LDS_WAIT() asm volatile("s_waitcnt lgkmcnt(0)" ::: "memory")
#define VM_WAIT() asm volatile("s_waitcnt vmcnt(0)" ::: "memory")
__device__ __forceinline__ unsigned pk2(float lo, float hi) { return pg8::cvt_pk_bf16(lo, hi); }
using pg8::bf_lo; using pg8::bf_hi;

#define XB_TMO      128
#define XB_XCNT(j)  (256  + 64 * (j))
#define XB_XSUB(j)  (1280 + 64 * (j))
#define XB_XGEN(j)  (2304 + 64 * (j))
#define XB_TOP      3328
#define XB_TOPGEN   3392
#define XCD_BAR_WORDS 3456
#define XB_SPIN_CAP (1u << 18)

__device__ __forceinline__ unsigned xb_ld(unsigned* p)              { return __hip_atomic_load(p, __ATOMIC_RELAXED, __HIP_MEMORY_SCOPE_AGENT); }
__device__ __forceinline__ unsigned xb_add(unsigned* p, unsigned v) { return __hip_atomic_fetch_add(p, v, __ATOMIC_RELAXED, __HIP_MEMORY_SCOPE_AGENT); }
__device__ __forceinline__ unsigned xb_xcc_id() { return (unsigned)__builtin_amdgcn_s_getreg((3 << 11) | 20) & 0xFu; }
#define XB_SPIN(cond, bar) do { unsigned _sp = 0; while (cond) { __builtin_amdgcn_s_sleep(1); \
    if ((++_sp & 255u) == 0u) { if (xb_ld(&(bar)[XB_TMO])) break; if (_sp > XB_SPIN_CAP) { atomicAdd(&(bar)[XB_TMO], 1u); break; } } } } while (0)

struct XcdBarrier { unsigned* bar; unsigned x; volatile LAS unsigned* st; };

__device__ __forceinline__ XcdBarrier xcd_barrier_post(unsigned* bar, volatile LAS unsigned* st) {
    XcdBarrier b; b.bar = bar; b.x = xb_xcc_id(); b.st = st;
    if (threadIdx.x == 0) (void)xb_add(&bar[XB_XCNT(b.x)], 1u);
    return b;
}
__device__ __forceinline__ void xcd_barrier_complete(unsigned* bar, unsigned x, unsigned& nloc, unsigned& nx) {
    const unsigned G = gridDim.x * gridDim.y * gridDim.z;
    unsigned sum, cnt, mine, sp = 0u;
    for (;;) {
        sum = 0u; cnt = 0u; mine = 0u;
#pragma unroll
        for (unsigned j = 0; j < 16; ++j) { const unsigned c = xb_ld(&bar[XB_XCNT(j)]); sum += c; cnt += (c > 0u) ? 1u : 0u; mine = (j == x) ? c : mine; }
        if (sum == G) break;
        __builtin_amdgcn_s_sleep(1);
        if ((++sp & 255u) == 0u) { if (xb_ld(&bar[XB_TMO])) break; if (sp > XB_SPIN_CAP) { atomicAdd(&bar[XB_TMO], 1u); break; } }
    }
    nloc = mine > 0u ? mine : 1u; nx = cnt > 0u ? cnt : 1u;
}
__device__ __forceinline__ void xcd_barrier(const XcdBarrier& b) {
    asm volatile("s_waitcnt vmcnt(0)" ::: "memory");
    __syncthreads();
    if (threadIdx.x == 0) {
        unsigned* bar = b.bar;
        __builtin_amdgcn_s_waitcnt(0);
        unsigned nloc = b.st[0], nx = b.st[1];
        if (nloc == 0u) { xcd_barrier_complete(bar, b.x, nloc, nx); b.st[0] = nloc; b.st[1] = nx; }
        const unsigned old = xb_add(&bar[XB_XSUB(b.x)], 1u);
        const unsigned gen = old / nloc;
        if (old + 1u == (gen + 1u) * nloc) {
            __builtin_amdgcn_fence(__ATOMIC_RELEASE, "agent");
            asm volatile("s_waitcnt vmcnt(0)" ::: "memory");
            const unsigned og = xb_add(&bar[XB_TOP], 1u);
            const unsigned tg = og / nx;
            if (og + 1u == (tg + 1u) * nx) xb_add(&bar[XB_TOPGEN], 1u);
            else XB_SPIN(xb_ld(&bar[XB_TOPGEN]) == tg, bar);
            __builtin_amdgcn_fence(__ATOMIC_ACQUIRE, "agent");
            xb_add(&bar[XB_XGEN(b.x)], 1u);
            asm volatile("s_waitcnt vmcnt(0)" ::: "memory");
        } else {
            XB_SPIN(xb_ld(&bar[XB_XGEN(b.x)]) == gen, bar);
            __builtin_amdgcn_fence(__ATOMIC_ACQUIRE, "agent");
            asm volatile("s_waitcnt vmcnt(0)" ::: "memory");
        }
    }
    __syncthreads();
}

struct Frame {
    LAS unsigned char* lds;
    int tid, lane, wave;
    int vcu, G;
};

__device__ __forceinline__ float wave_sum(float v) {
#pragma unroll
    for (int o = 1; o < 64; o <<= 1) v += __shfl_xor(v, o);
    return v;
}

struct TrJob { const float* W; bf16* WT; int K, N, sh, roff, ldo, koff, ncv; const float* kscale; };
__device__ __forceinline__ void tr_load(const TrJob& J, int it, int lane, f32x4 (&v)[8]) {
    const int nblk = J.ncv >> 5, kb = it / nblk, nb = it - kb * nblk;
    const float* src = J.W + (size_t)(kb * 64 + 2 * (lane >> 3)) * J.N + nb * 32 + 4 * (lane & 7);
#pragma unroll
    for (int i = 0; i < 8; ++i) v[i] = __builtin_nontemporal_load((const GAS f32x4*)(src + (size_t)(16 * (i >> 1) + (i & 1)) * J.N));
    if (J.kscale) {
#pragma unroll
        for (int i = 0; i < 8; ++i) v[i] = v[i] * J.kscale[kb * 64 + 2 * (lane >> 3) + 16 * (i >> 1) + (i & 1)];
    }
}
__device__ __forceinline__ void tr_store(const TrJob& J, int it, int lane, const f32x4 (&v)[8], LAS unsigned* T) {
    const int nblk = J.ncv >> 5, kb = it / nblk, nb = it - kb * nblk;
#pragma unroll
    for (int ip = 0; ip < 4; ++ip)
#pragma unroll
        for (int j = 0; j < 4; ++j) T[(4 * (lane & 7) + j) * 33 + 8 * ip + (lane >> 3)] = pk2(v[2 * ip][j], v[2 * ip + 1][j]);
    LDS_WAIT(); asm volatile("" ::: "memory");
#pragma unroll
    for (int jp = 0; jp < 4; ++jp) { const int nl = 8 * jp + (lane >> 3), c = lane & 7; const LAS unsigned* s = T + nl * 33 + 4 * c;
        v4u o; o.x = s[0]; o.y = s[1]; o.z = s[2]; o.w = s[3];
        const int n = nb * 32 + nl; const int orow0 = ((n >> 7) << (7 + J.sh)) + (n & 127) + J.roff, orow = (orow0 & ~31) + pg8::invperm32(orow0 & 31);
        *(GAS v4u*)((GAS char*)J.WT + blk_off(orow, J.koff + kb * 64 + 8 * c, J.ldo)) = o; }
    LDS_WAIT(); asm volatile("" ::: "memory");
}
__device__ __forceinline__ void tr_run(const TrJob& J, int w0, int nw, int lane, LAS unsigned* T) {
    const int nitems = (J.K >> 6) * (J.ncv >> 5);
    f32x4 va[8], vb[8];
    int it = w0;
    if (it < nitems) tr_load(J, it, lane, va);
    while (it < nitems) {
        const int it2 = it + nw;
        if (it2 < nitems) tr_load(J, it2, lane, vb);
        tr_store(J, it, lane, va, T);
        if (it2 >= nitems) break;
        const int it3 = it2 + nw;
        if (it3 < nitems) tr_load(J, it3, lane, va);
        tr_store(J, it2, lane, vb, T);
        it = it3;
    }
}

__device__ __forceinline__ size_t blk8_off(int r, int k, int Kb) { return ((size_t)(r >> 8) * (size_t)(Kb >> 7) + (size_t)(k >> 7)) * 32768u + (size_t)((r & 255) * 128 + (k & 127)); }
__device__ __forceinline__ unsigned pk4_fp8(float a, float b, float c, float d) { int w = __builtin_amdgcn_cvt_pk_fp8_f32(a, b, 0, false); w = __builtin_amdgcn_cvt_pk_fp8_f32(c, d, w, true); return (unsigned)w; }
__device__ __forceinline__ void w8_load(const float* W, int N, int c0, int nnb, int it, int lane, float (&v)[16], const float* kscale) {
    const int kc = it / nnb, nb = it - kc * nnb; const float* src = W + (size_t)(kc * 16) * N + c0 + nb * 64 + lane;
#pragma unroll
    for (int i = 0; i < 16; ++i) v[i] = __builtin_nontemporal_load((const GAS float*)(src + (size_t)i * N)) * kscale[kc * 16 + i];
}
__device__ __forceinline__ void w8_store(unsigned char* W8, int K, int nnb, int it, int lane, float scale, const float (&v)[16]) {
    const int kc = it / nnb, nb = it - kc * nnb, n = nb * 64 + lane, k0 = kc * 16;
    v4u o; o.x = pk4_fp8(v[0] * scale, v[1] * scale, v[2] * scale, v[3] * scale); o.y = pk4_fp8(v[4] * scale, v[5] * scale, v[6] * scale, v[7] * scale);
    o.z = pk4_fp8(v[8] * scale, v[9] * scale, v[10] * scale, v[11] * scale); o.w = pk4_fp8(v[12] * scale, v[13] * scale, v[14] * scale, v[15] * scale);
    *(GAS v4u*)((GAS unsigned char*)W8 + blk8_off((n & ~31) + pg8::invperm32(n & 31), k0, K)) = o;
}
__device__ __forceinline__ void w8_run(const float* W, unsigned char* W8, int K, int N, int c0, int ncv, float scale, int w0, int nw, int lane, const float* kscale) {
    const int nnb = ncv >> 6, nitems = (K >> 4) * nnb;
    float va[16], vb[16], vc[16];
    int it = w0;
    if (it < nitems) w8_load(W, N, c0, nnb, it, lane, va, kscale);
    if (it + nw < nitems) w8_load(W, N, c0, nnb, it + nw, lane, vb, kscale);
    while (it < nitems) {
        if (it + 2 * nw < nitems) w8_load(W, N, c0, nnb, it + 2 * nw, lane, vc, kscale);
        w8_store(W8, K, nnb, it, lane, scale, va);
        if (it + nw >= nitems) break;
        if (it + 3 * nw < nitems) w8_load(W, N, c0, nnb, it + 3 * nw, lane, va, kscale);
        w8_store(W8, K, nnb, it + nw, lane, scale, vb);
        if (it + 2 * nw >= nitems) break;
        if (it + 4 * nw < nitems) w8_load(W, N, c0, nnb, it + 4 * nw, lane, vb, kscale);
        w8_store(W8, K, nnb, it + 2 * nw, lane, scale, vc);
        it += 3 * nw;
    }
}

template <int MODE, bool XIN16 = false, bool FOLD = false>
__device__ __forceinline__ void row_phase(const Frame& F, int nrows, int split, const float* xa, const float* xb, const bf16* t, const float* g_post, float alpha, const float* g_next, float* xout, bf16* hout, unsigned char* h8out = nullptr, float* rsout = nullptr, const float* rsin = nullptr) {
    const int gw = F.vcu * NWAVES + F.wave, NGW = F.G * NWAVES, tid = launder_tid(), lane = tid & 63;
    const unsigned o16 = (unsigned)lane * 16u, o8 = (unsigned)lane * 8u;
    __syncthreads();
    for (int i = tid; i < D / 4; i += NWAVES * 64) { if (MODE != 0) ((LAS f32x4*)F.lds)[i] = ((const GAS f32x4*)g_post)[i]; if (!FOLD) ((LAS f32x4*)(F.lds + 16384))[i] = ((const GAS f32x4*)g_next)[i]; }
    __syncthreads();
    const LAS unsigned char* lgp = F.lds + o16; const LAS unsigned char* lgn = F.lds + 16384 + o16;
#define RP_F4(base, j) (*(const GAS f32x4*)((const GAS char*)(base) + (o16 + (unsigned)(j) * 1024u)))
#define RP_H4(base, j) (*(const GAS v2u*)((const GAS char*)(base) + (o8 + (unsigned)(j) * 512u)))
    const unsigned hoff0 = (unsigned)(lane >> 4) * 32768u + (unsigned)(lane & 15) * 8u;
    const unsigned h8off0 = (unsigned)(lane >> 5) * 32768u + (unsigned)(lane & 31) * 4u;
    for (int row = gw; row < nrows; row += NGW) {
        asm volatile("" ::: "memory");
        unsigned hoff = hoff0, h8off = h8off0; asm volatile("" : "+v"(hoff), "+v"(h8off));
        const float* xr = (row < split) ? xa + (size_t)row * D : xb + (size_t)(row - split) * D;
        const size_t rblk = (size_t)(row >> 8) * 64 * 32768 + (size_t)(row & 255) * 128;
        f32x4 x[16];
        if (XIN16) { const GAS char* xb16 = (const GAS char*)xa + rblk; const float ri = rsin[row];
#pragma unroll
            for (int j = 0; j < 16; ++j) { const v2u w = *(const GAS v2u*)(xb16 + (hoff + (unsigned)j * 131072u)); x[j] = (f32x4){bf_lo(w.x) * ri, bf_hi(w.x) * ri, bf_lo(w.y) * ri, bf_hi(w.y) * ri}; } }
        else {
#pragma unroll
            for (int j = 0; j < 16; ++j) x[j] = RP_F4(xr, j); }
        if (MODE != 0) {
            const bf16* tr = t + (size_t)row * D;
            v2u tv[16]; float ss = 0.f;
#pragma unroll
            for (int j = 0; j < 16; ++j) tv[j] = RP_H4(tr, j);
#pragma unroll
            for (int j = 0; j < 16; ++j) { const float a = bf_lo(tv[j].x), b = bf_hi(tv[j].x), c = bf_lo(tv[j].y), d = bf_hi(tv[j].y); ss += (a * a + b * b) + (c * c + d * d); }
            const float rs = alpha * __builtin_amdgcn_rsqf(wave_sum(ss) * (1.f / D) + RMS_EPS);
#pragma unroll
            for (int j = 0; j < 16; ++j) { const f32x4 gp = *(const LAS f32x4*)(lgp + j * 1024);
                x[j].x += rs * bf_lo(tv[j].x) * gp.x; x[j].y += rs * bf_hi(tv[j].x) * gp.y; x[j].z += rs * bf_lo(tv[j].y) * gp.z; x[j].w += rs * bf_hi(tv[j].y) * gp.w; }
        }
        float s2 = 0.f;
#pragma unroll
        for (int j = 0; j < 16; ++j) s2 += (x[j].x * x[j].x + x[j].y * x[j].y) + (x[j].z * x[j].z + x[j].w * x[j].w);
        const float ms = wave_sum(s2) * (1.f / D) + RMS_EPS, r2 = __builtin_amdgcn_rsqf(ms);
        const GAS char* h8 = (const GAS char*)h8out + ((size_t)(row >> 8) * 32 * 32768 + (size_t)(row & 255) * 128);
        if (FOLD) {
            if (lane == 0) rsout[row] = ms * r2;
            const GAS char* xob = (const GAS char*)xout + rblk;
#pragma unroll
            for (int j = 0; j < 16; ++j) { const f32x4 y = (f32x4){x[j].x * r2, x[j].y * r2, x[j].z * r2, x[j].w * r2};
                v2u o; o.x = pk2(y.x, y.y); o.y = pk2(y.z, y.w); *(GAS v2u*)((GAS char*)xob + (hoff + (unsigned)j * 131072u)) = o;
                if (h8out) *(GAS unsigned*)((GAS char*)h8 + (h8off + (unsigned)j * 65536u)) = pk4_fp8(y.x, y.y, y.z, y.w); }
        } else {
            float* xo2 = xout + (size_t)row * D;
            const GAS char* ho = (const GAS char*)hout + rblk;
#pragma unroll
            for (int j = 0; j < 16; ++j) { const f32x4 gn = *(const LAS f32x4*)(lgn + j * 1024);
                const f32x4 y = (f32x4){x[j].x * r2 * gn.x, x[j].y * r2 * gn.y, x[j].z * r2 * gn.z, x[j].w * r2 * gn.w};
                if (MODE == 2) *(GAS f32x4*)((GAS char*)xo2 + (o16 + (unsigned)j * 1024u)) = y;
                else { v2u o; o.x = pk2(y.x, y.y); o.y = pk2(y.z, y.w); *(GAS v2u*)((GAS char*)ho + (hoff + (unsigned)j * 131072u)) = o; } }
        }
    }
#undef RP_F4
#undef RP_H4
    __syncthreads();
}

__device__ __forceinline__ bf16x8 pack_p(const f32x4 a, const f32x4 b) {
    const unsigned w0 = pk2(a[0], a[1]), w1 = pk2(a[2], a[3]), w2 = pk2(b[0], b[1]), w3 = pk2(b[2], b[3]);
    v4u w = (v4u){w0, w1, w2, w3}; return __builtin_bit_cast(bf16x8, w);
}
#define MEMFENCE() asm volatile("" ::: "memory")
#define WG_BAR() do { asm volatile("s_waitcnt lgkmcnt(0)" ::: "memory"); __builtin_amdgcn_s_barrier(); asm volatile("" ::: "memory"); } while (0)
constexpr int NA_KP = 272, NA_VP = 288, NA_KBUF = 2 * 64 * NA_KP, NA_VBUF = 2 * 64 * NA_VP;
constexpr int MX_KP = 528, MX_VP = 544, MX_KBUF = 64 * MX_KP, MX_VBUF = 32 * MX_VP;
constexpr int ATT_BIAS_OFF = 2 * NA_VBUF;
static_assert(2 * NA_KBUF <= ATT_BIAS_OFF && 2 * MX_KBUF <= ATT_BIAS_OFF && 2 * MX_VBUF <= ATT_BIAS_OFF && ATT_BIAS_OFF + 8 * 2048 <= RING_BYTES, "attention LDS map");

__device__ __forceinline__ void na_unit(const bf16* z, const float* rpb, bf16* Aout, int R, int hp, LAS unsigned char* lds, int tid) {
    const int lane = tid & 63, wave = __builtin_amdgcn_readfirstlane(tid >> 6), hl = wave >> 2, qg = wave & 3, h = 2 * hp + hl;
    const int q = lane & 15, kq = lane >> 4;
    int seq0, rows; if (R < 256) { seq0 = 0; rows = 256; } else if (R < 320) { seq0 = 256; rows = 64; } else { seq0 = 320; rows = 64; }
    const int r = R - seq0; int rs = r - 4; rs = rs < 0 ? 0 : (rs > rows - 8 ? rows - 8 : rs);
    const int krow0 = seq0 + rs, c0 = 16 * qg, cb = (qg == 0) ? 0 : (qg == 1) ? 8 : (qg == 2) ? 24 : 32;
    LAS float* bl = (LAS float*)(lds + ATT_BIAS_OFF + wave * 2048);
#pragma unroll
    for (int k = 0; k < 4; ++k) { const int idx = lane + 64 * k, i = idx >> 5, co = idx & 31; if (co < 31) bl[i * 64 + 16 + co] = rpb[h * 465 + (rs + i - r + 7) * 31 + co]; }
    bf16x8 qf[4]; { const bf16* qp = z + (size_t)(R * 64 + c0 + q) * ZW + OQ + h * 128 + 8 * kq;
#pragma unroll
        for (int ks = 0; ks < 4; ++ks) qf[ks] = *(const GAS bf16x8*)(qp + 32 * ks); }
    const int skey = tid >> 5, sch = tid & 31;
    const bf16* ksrc = z + (size_t)(krow0 * 64 + skey) * ZW + OKA + hp * 256 + 8 * sch;
    const int kdst = (sch >> 4) * (64 * NA_KP) + skey * NA_KP + (sch & 15) * 16, vdst = (sch >> 4) * (64 * NA_VP) + skey * NA_VP + (sch & 15) * 16;
#define NA_LD(dst, src, i) do { _Pragma("unroll") for (int v = 0; v < 4; ++v) dst[v] = *(const GAS v4u*)((src) + (size_t)((i) * 64 + 16 * v) * ZW); } while (0)
#define NA_ST(srcr, off, pitch) do { _Pragma("unroll") for (int v = 0; v < 4; ++v) *(LAS v4u*)(lds + (off) + v * 16 * (pitch)) = srcr[v]; } while (0)
    v4u ra[4], rb[4], rc[4];
    NA_LD(ra, ksrc, 0); NA_LD(rb, ksrc, 1); NA_LD(rc, ksrc, 2);
    f32x4 S[8][2];
    const int kfo = hl * (64 * NA_KP) + (cb + q) * NA_KP + kq * 16;
    WG_BAR();
#define NA_QK(i, b) do { const LAS unsigned char* kb_ = lds + (b) * NA_KBUF + kfo; _Pragma("unroll") for (int hf = 0; hf < 2; ++hf) { f32x4 a_ = (f32x4){0.f, 0.f, 0.f, 0.f}; \
        _Pragma("unroll") for (int ks = 0; ks < 4; ++ks) a_ = __builtin_amdgcn_mfma_f32_16x16x32_bf16(*(const LAS bf16x8*)(kb_ + hf * 16 * NA_KP + ks * 64), qf[ks], a_, 0, 0, 0); S[i][hf] = a_; } } while (0)
#define NA_KSTEP(i, reg) do { NA_ST(reg, ((i) & 1) * NA_KBUF + kdst, NA_KP); if ((i) + 3 < 8) NA_LD(reg, ksrc, (i) + 3); else NA_LD(reg, ksrc + (OVA - OKA), (i) + 3 - 8); WG_BAR(); NA_QK(i, (i) & 1); } while (0)
    NA_KSTEP(0, ra); NA_KSTEP(1, rb); NA_KSTEP(2, rc); NA_KSTEP(3, ra); NA_KSTEP(4, rb); NA_KSTEP(5, rc); NA_KSTEP(6, ra); NA_KSTEP(7, rb);
    const int c = c0 + q; int cs = c - 8; cs = cs < 0 ? 0 : (cs > 48 ? 48 : cs);
    const float scale = 0.08838834764831845f, NEG = -1e30f;
    float mx = NEG;
#pragma unroll
    for (int i = 0; i < 8; ++i)
#pragma unroll
        for (int hf = 0; hf < 2; ++hf)
#pragma unroll
            for (int e = 0; e < 4; ++e) { const int col = cb + 16 * hf + 4 * kq + e; const bool ok = (unsigned)(col - cs) < 16u;
                const float b = bl[i * 64 + 16 + (col - c + 15)];
                const float s_ = ok ? (S[i][hf][e] * scale + b) : NEG; S[i][hf][e] = s_; mx = fmaxf(mx, s_); }
    mx = fmaxf(mx, __shfl_xor(mx, 16)); mx = fmaxf(mx, __shfl_xor(mx, 32));
    float l = 0.f;
#pragma unroll
    for (int i = 0; i < 8; ++i)
#pragma unroll
        for (int hf = 0; hf < 2; ++hf)
#pragma unroll
            for (int e = 0; e < 4; ++e) { const float p = __builtin_amdgcn_exp2f((S[i][hf][e] - mx) * 1.44269504089f); S[i][hf][e] = p; l += p; }
    l += __shfl_xor(l, 16); l += __shfl_xor(l, 32);
    f32x4 O[8];
#pragma unroll
    for (int db = 0; db < 8; ++db) O[db] = (f32x4){0.f, 0.f, 0.f, 0.f};
    const int vfo = hl * (64 * NA_VP) + (cb + 4 * kq + ((lane & 15) >> 2)) * NA_VP + 8 * (lane & 3);
    const bf16* vsrc = ksrc + (OVA - OKA);
    WG_BAR();
#define NA_PV(i, b) do { const LAS unsigned char* r0_ = lds + (b) * NA_VBUF + vfo; const bf16x8 pf_ = pack_p(S[i][0], S[i][1]); _Pragma("unroll") for (int db = 0; db < 8; ++db) { \
        const s16x4 lo_ = __builtin_amdgcn_ds_read_tr16_b64_v4i16((LAS s16x4*)(r0_ + 32 * db)), hi_ = __builtin_amdgcn_ds_read_tr16_b64_v4i16((LAS s16x4*)(r0_ + 16 * NA_VP + 32 * db)); \
        O[db] = __builtin_amdgcn_mfma_f32_16x16x32_bf16((bf16x8){lo_[0], lo_[1], lo_[2], lo_[3], hi_[0], hi_[1], hi_[2], hi_[3]}, pf_, O[db], 0, 0, 0); } } while (0)
#define NA_VSTEP(i, reg) do { NA_ST(reg, ((i) & 1) * NA_VBUF + vdst, NA_VP); if ((i) + 3 < 8) NA_LD(reg, vsrc, (i) + 3); WG_BAR(); NA_PV(i, (i) & 1); } while (0)
    NA_VSTEP(0, rc); NA_VSTEP(1, ra); NA_VSTEP(2, rb); NA_VSTEP(3, rc); NA_VSTEP(4, ra); NA_VSTEP(5, rb); NA_VSTEP(6, rc); NA_VSTEP(7, ra);
#undef NA_LD
#undef NA_ST
#undef NA_QK
#undef NA_KSTEP
#undef NA_PV
#undef NA_VSTEP
    const float inv = 1.0f / l;
#pragma unroll
    for (int db = 0; db < 8; ++db) { v2u o; o.x = pk2(O[db][0] * inv, O[db][1] * inv); o.y = pk2(O[db][2] * inv, O[db][3] * inv);
        *(GAS v2u*)((GAS char*)Aout + blk_off(R * 64 + c0 + q, h * 128 + 16 * db + 4 * kq, D)) = o; }
}

__device__ __forceinline__ void mx_unit(const bf16* z, const bf16* kvmem, bf16* Cout, int tb2, int hc, LAS unsigned char* lds, int tid) {
    const int lane = tid & 63, wave = __builtin_amdgcn_readfirstlane(tid >> 6), q = lane & 15, kq = lane >> 4, tok0 = 128 * tb2 + 16 * wave;
    const int bq = tb2 < (NPROMPT >> 7) ? 0 : 1 + ((tb2 - (NPROMPT >> 7)) >> 5);
    const bf16* kv = kvmem + (size_t)bq * 256 * KVW;
    const int skey = tid >> 5, sch = tid & 31;
    const bf16* ksrc = kv + (size_t)skey * KVW + hc * 256 + 8 * sch;
    const bf16* vsrc = ksrc + 1024;
    const int kdst = skey * MX_KP + sch * 16, vdst = skey * MX_VP + sch * 16;
    bf16x8 pf[8]; float l;
    {
        bf16x8 qf[8]; { const bf16* qp = z + (size_t)(tok0 + q) * ZW + OQC + hc * 256 + 8 * kq;
#pragma unroll
            for (int ks = 0; ks < 8; ++ks) qf[ks] = *(const GAS bf16x8*)(qp + 32 * ks); }
        v4u ra[4], rb[4], rc[4];
#define MX_KLD(dst, j) do { _Pragma("unroll") for (int v = 0; v < 4; ++v) dst[v] = *(const GAS v4u*)(ksrc + (size_t)(64 * (j) + 16 * v) * KVW); } while (0)
#define MX_KST(srcr, b) do { _Pragma("unroll") for (int v = 0; v < 4; ++v) *(LAS v4u*)(lds + (b) * MX_KBUF + kdst + v * 16 * MX_KP) = srcr[v]; } while (0)
        MX_KLD(ra, 0); MX_KLD(rb, 1); MX_KLD(rc, 2);
        f32x4 S[16];
        const int kfo = q * MX_KP + kq * 16;
        WG_BAR();
#define MX_QK(j, b) do { _Pragma("unroll") for (int t = 0; t < 4; ++t) { const LAS unsigned char* kb_ = lds + (b) * MX_KBUF + kfo + t * 16 * MX_KP; f32x4 a_ = (f32x4){0.f, 0.f, 0.f, 0.f}; \
        _Pragma("unroll") for (int ks = 0; ks < 8; ++ks) a_ = __builtin_amdgcn_mfma_f32_16x16x32_bf16(*(const LAS bf16x8*)(kb_ + ks * 64), qf[ks], a_, 0, 0, 0); S[4 * (j) + t] = a_; } } while (0)
        MX_KST(ra, 0); MX_KLD(ra, 3); WG_BAR(); MX_QK(0, 0);
        MX_KST(rb, 1); WG_BAR(); MX_QK(1, 1);
        MX_KST(rc, 0); WG_BAR(); MX_QK(2, 0);
        MX_KST(ra, 1); WG_BAR(); MX_QK(3, 1);
#undef MX_KLD
#undef MX_KST
#undef MX_QK
        float mx = -1e30f;
#pragma unroll
        for (int kt = 0; kt < 16; ++kt)
#pragma unroll
            for (int e = 0; e < 4; ++e) mx = fmaxf(mx, S[kt][e]);
        mx = fmaxf(mx, __shfl_xor(mx, 16)); mx = fmaxf(mx, __shfl_xor(mx, 32));
        l = 0.f; const float sc = 0.0625f * 1.44269504089f;
#pragma unroll
        for (int kt = 0; kt < 16; ++kt)
#pragma unroll
            for (int e = 0; e < 4; ++e) { const float p = __builtin_amdgcn_exp2f((S[kt][e] - mx) * sc); S[kt][e] = p; l += p; }
        l += __shfl_xor(l, 16); l += __shfl_xor(l, 32);
#pragma unroll
        for (int kb = 0; kb < 8; ++kb) pf[kb] = pack_p(S[2 * kb], S[2 * kb + 1]);
    }
    const float inv = 1.0f / l;
    v4u va[2], vb[2], vc[2];
#define MX_VLD(dst, s_) do { _Pragma("unroll") for (int v = 0; v < 2; ++v) dst[v] = *(const GAS v4u*)(vsrc + (size_t)(32 * (s_) + 16 * v) * KVW); } while (0)
#define MX_VST(srcr, b) do { _Pragma("unroll") for (int v = 0; v < 2; ++v) *(LAS v4u*)(lds + (b) * MX_VBUF + vdst + v * 16 * MX_VP) = srcr[v]; } while (0)
    MX_VLD(va, 0); MX_VLD(vb, 1); MX_VLD(vc, 2);
    f32x4 O[16];
#pragma unroll
    for (int db = 0; db < 16; ++db) O[db] = (f32x4){0.f, 0.f, 0.f, 0.f};
    const int vfo = (4 * kq + ((lane & 15) >> 2)) * MX_VP + 8 * (lane & 3);
    WG_BAR();
#define MX_PV(s_, b) do { const LAS unsigned char* r0_ = lds + (b) * MX_VBUF + vfo; _Pragma("unroll") for (int db = 0; db < 16; ++db) { \
        const s16x4 lo_ = __builtin_amdgcn_ds_read_tr16_b64_v4i16((LAS s16x4*)(r0_ + 32 * db)), hi_ = __builtin_amdgcn_ds_read_tr16_b64_v4i16((LAS s16x4*)(r0_ + 16 * MX_VP + 32 * db)); \
        O[db] = __builtin_amdgcn_mfma_f32_16x16x32_bf16((bf16x8){lo_[0], lo_[1], lo_[2], lo_[3], hi_[0], hi_[1], hi_[2], hi_[3]}, pf[s_], O[db], 0, 0, 0); } } while (0)
#define MX_VSTEP(s_, reg) do { MX_VST(reg, (s_) & 1); if ((s_) + 3 < 8) MX_VLD(reg, (s_) + 3); WG_BAR(); MX_PV(s_, (s_) & 1); } while (0)
    MX_VSTEP(0, va); MX_VSTEP(1, vb); MX_VSTEP(2, vc); MX_VSTEP(3, va); MX_VSTEP(4, vb); MX_VSTEP(5, vc); MX_VSTEP(6, va); MX_VSTEP(7, vb);
#undef MX_VLD
#undef MX_VST
#undef MX_PV
#undef MX_VSTEP
#pragma unroll
    for (int db = 0; db < 16; ++db) { v2u o; o.x = pk2(O[db][0] * inv, O[db][1] * inv); o.y = pk2(O[db][2] * inv, O[db][3] * inv);
        *(GAS v2u*)((GAS char*)Cout + blk_off(tok0 + q, 3072 + hc * 256 + 16 * db + 4 * kq, D)) = o; }
}

template <int G> __device__ __forceinline__ void pool_item(const bf16* z, bf16* pooled, int tb, int lane) {
    constexpr int HW = 1 << G, NR = 16 + 2 * HW;
    const int t0g = 16 * tb; int sbase, L; if (t0g < NPROMPT) { sbase = 0; L = NPROMPT; } else { sbase = NPROMPT + (((t0g - NPROMPT) >> 12) << 12); L = 4096; }
    const int t0 = t0g - sbase;
    f32x4 rv[NR];
#pragma unroll
    for (int k = 0; k < NR; ++k) { const int s = t0 - HW + k; const bool ok = (s >= 0) && (s < L); const int sc = ok ? s : t0;
        const v2u w = *(const GAS v2u*)(z + (size_t)(sbase + sc) * ZW + OU + 256 * G + 4 * lane);
        rv[k] = ok ? (f32x4){bf_lo(w.x), bf_hi(w.x), bf_lo(w.y), bf_hi(w.y)} : (f32x4){0.f, 0.f, 0.f, 0.f}; }
    f32x4 win = (f32x4){0.f, 0.f, 0.f, 0.f};
#pragma unroll
    for (int k = 0; k < 2 * HW; ++k) win += rv[k];
#pragma unroll
    for (int j = 0; j < 16; ++j) { const int t = t0 + j; const int lo = (t - HW) < 0 ? 0 : (t - HW), hi = (t + HW) > L ? L : (t + HW);
        const float ic = 1.0f / (float)(hi - lo); const f32x4 pz = win * ic - rv[j + HW];
        v2u o; o.x = pk2(pz.x, pz.y); o.y = pk2(pz.z, pz.w);
        *(GAS v2u*)((GAS char*)pooled + blk_off(t0g + j, 256 * G + 4 * lane, 1024)) = o;
        if (j < 15) win += rv[j + 2 * HW] - rv[j]; }
}

struct Args { const float* in[28]; float* out; unsigned char* ws; int ph_lo, ph_hi; };
__global__ void __launch_bounds__(NWAVES * 64, 2) mk_fwd(Args args) {
    extern __shared__ __attribute__((aligned(16))) unsigned char lds[];
    Frame F;
    F.lds = (LAS unsigned char*)lds;
    F.tid = threadIdx.x; F.lane = F.tid & 63; F.wave = __builtin_amdgcn_readfirstlane(F.tid >> 6);
    F.G = gridDim.x; { const int bx = blockIdx.x; F.vcu = (F.G % 8 == 0) ? (bx % 8) * (F.G / 8) + bx / 8 : bx; }
    unsigned char* ws = args.ws;
    gu32* ctl = (gu32*)(ws + WS_CTL);
    for (int u = F.tid; u < (LDS_BYTES - LDSCTL_OFF) / 4; u += NWAVES * 64) ((LAS unsigned*)(F.lds + LDSCTL_OFF))[u] = 0u;
    __syncthreads();
    XcdBarrier bar; bar.bar = (unsigned*)(ctl + CW_BAR); bar.x = 0; bar.st = nullptr;
    if (MK_N_LAUNCHES == 1) bar = xcd_barrier_post((unsigned*)(ctl + CW_BAR), (volatile LAS unsigned*)(F.lds + MISC_OFF) + 8);
    const int lo = args.ph_lo, hi = args.ph_hi;
#ifndef PH_MASK
#define PH_MASK 0x1fff
#endif
#define IN(k) (((PH_MASK >> (k)) & 1) && lo <= (k) && (k) < hi)
#define SEAM(k) do { if (IN(k) && IN((k) + 1)) xcd_barrier(bar); } while (0)

    const float* x_prompt = args.in[0]; const float* x_sample = args.in[1]; const float* mem_prompt = args.in[2]; const float* mem_sample = args.in[3];
    const float* g_ffn1_pre = args.in[4]; const float* w1_gate = args.in[5]; const float* w1_up = args.in[6]; const float* w1_down = args.in[7]; const float* g_ffn1_post = args.in[8];
    const float* g_mix_pre = args.in[9]; const float* w_in = args.in[10]; const float* rpb = args.in[11]; const float* w_pool = args.in[12]; const float* pool_scale = args.in[13];
    const float* g_mem = args.in[14]; const float* w_mem_kv = args.in[15]; const float* w_a_out = args.in[16]; const float* w_b_out = args.in[17]; const float* w_c_out = args.in[18];
    const float* b_gate = args.in[19]; const float* w_o = args.in[20]; const float* g_mix_post = args.in[21]; const float* g_ffn2_pre = args.in[22];
    const float* w2_gate = args.in[23]; const float* w2_up = args.in[24]; const float* w2_down = args.in[25]; const float* g_ffn2_post = args.in[26]; const float* g_final = args.in[27];
    float* out = args.out;
    bf16* MEMN = (bf16*)(ws + WS_MEMN); bf16* KVMEM = (bf16*)(ws + WS_KVMEM); bf16* WPOOLT = (bf16*)(ws + WS_WPOOL); bf16* WMEMKVT = (bf16*)(ws + WS_WMEMKV);
    bf16* WCAT = (bf16*)(ws + WS_WA); bf16* WOT = (bf16*)(ws + WS_WO); bf16* WINT = (bf16*)(ws + WS_WIN);
    bf16* WGUT = (bf16*)(ws + WS_WGU); bf16* WDT = (bf16*)(ws + WS_WD); bf16* POOLED = (bf16*)(ws + WS_POOLED);
    float* RS2 = (float*)(ws + WS_CTL + 128 * 1024); float* RS3 = (float*)(ws + WS_CTL + 256 * 1024);
    unsigned char* H8 = ws + WS_H8; unsigned char* W8G = ws + WS_W8G; bf16* HB = (bf16*)(ws + WS_H); bf16* TB = (bf16*)(ws + WS_T); bf16* ABC = (bf16*)(ws + WS_T);
    bf16* HID = (bf16*)(ws + WS_BIG); bf16* Z = (bf16*)(ws + WS_BIG); bf16* X2 = (bf16*)(ws + WS_BIG + 600 * MiB);
    const int gw = F.vcu * NWAVES + F.wave, NGW = F.G * NWAVES;
    LAS unsigned* trT = (LAS unsigned*)(F.lds + F.wave * 4352);

    if (IN(0)) {
        const int lane0 = launder_tid() & 63;
        row_phase<0>(F, NTOK, NPROMPT, x_prompt, x_sample, nullptr, nullptr, 0.f, g_ffn1_pre, nullptr, HB);
        row_phase<0>(F, NMEMROW, 256, mem_prompt, mem_sample, nullptr, nullptr, 0.f, g_mem, nullptr, MEMN);
        { TrJob J{w1_gate, WGUT, D, DFF, 1, 0, D, 0, DFF}; tr_run(J, gw, NGW, lane0, trT); }
        { TrJob J{w1_up, WGUT, D, DFF, 1, 128, D, 0, DFF}; tr_run(J, gw, NGW, lane0, trT); }
        { TrJob J{w_mem_kv, WMEMKVT, D, KVW, 0, 0, D, 0, KVW}; tr_run(J, gw, NGW, lane0, trT); }
        { TrJob J{w1_down, WDT, DFF, D, 0, 0, DFF, 0, D}; tr_run(J, gw, NGW, lane0, trT); }
    }
    SEAM(0);
    if (IN(1)) {
        { pg8::Gemm g{HB, WGUT, NTOK, 2 * DFF, D, D, 0}; pg8::XcdOrder S; S.init(NTOK, 2 * DFF, F.G, (int)blockIdx.x);
          pg8::EpiSwiGLU E{HID, DFF}; pg8::gemm_phase(F.lds, g, S, E); }
        { const int c2 = (int)blockIdx.x - 64;
          pg8::Gemm g{MEMN, WMEMKVT, NMEMROW, KVW, D, D, 0}; pg8::StaticOrder S; S.init(NMEMROW, KVW, 24, (c2 >= 0 && c2 < 24) ? c2 : -1);
          pg8::EpiStore E{KVMEM, KVW, nullptr, 1.f}; pg8::gemm_phase(F.lds, g, S, E); }
        if ((int)blockIdx.x >= 88) { __syncthreads();
            const int w0 = ((int)blockIdx.x - 88) * NWAVES + F.wave, nw = (F.G - 88) * NWAVES, lane1 = launder_tid() & 63;
            { TrJob J{w_in, WINT, D, ZW, 0, 0, D, 0, OGATE, g_mix_pre}; tr_run(J, w0, nw, lane1, trT); }
            { TrJob J{w_a_out, WCAT, 2048, D, 0, 0, D, 0, D}; tr_run(J, w0, nw, lane1, trT); }
            { TrJob J{w_b_out, WCAT, 1024, D, 0, 0, D, 2048, D}; tr_run(J, w0, nw, lane1, trT); }
            { TrJob J{w_c_out, WCAT, 1024, D, 0, 0, D, 3072, D}; tr_run(J, w0, nw, lane1, trT); }
            { TrJob J{w_o, WOT, D, D, 0, 0, D, 0, D}; tr_run(J, w0, nw, lane1, trT); }
#pragma unroll 1
            for (int g = 0; g < 4; ++g) { TrJob J{w_pool + (size_t)g * 65536, WPOOLT + (size_t)g * 65536, 256, 256, 0, 0, 256, 0, 256}; tr_run(J, w0, nw, lane1, trT); } }
    }
    SEAM(1);
    if (IN(2)) { pg8::Gemm g{HID, WDT, NTOK, D, DFF, DFF, 0}; pg8::XcdOrder S; S.init(NTOK, D, F.G, (int)blockIdx.x, 2);
        pg8::EpiStore E{TB, D, nullptr, 1.f}; pg8::gemm_phase(F.lds, g, S, E); }
    SEAM(2);
    if (IN(3)) { row_phase<1, false, true>(F, NTOK, NPROMPT, x_prompt, x_sample, TB, g_ffn1_post, 0.5f, nullptr, out, nullptr, H8, RS2);
        w8_run(w_in, W8G, D, ZW, OGATE, 3 * D, 64.f, gw, NGW, launder_tid() & 63, g_mix_pre); }
    SEAM(3);
    if (IN(4)) { pg8::Gemm g{(const bf16*)out, WINT, NTOK, OGATE, D, D, 0}; pg8::XcdOrder S; S.init(NTOK, OGATE, F.G, (int)blockIdx.x);
        pg8::EpiStore E{Z, ZW, nullptr, 1.f}; pg8::gemm_phase(F.lds, g, S, E); }
    SEAM(4);
    if (IN(5)) {
        const int tid5 = launder_tid(), lane5 = tid5 & 63;
#pragma unroll 1
        for (int rd = 0; rd < 3; ++rd) { const int item = (F.vcu * 3 + rd) * NWAVES + F.wave; if (item < 6144) {
            const int tb = item >> 2, g = item & 3;
            if (g == 0) pool_item<0>(Z, POOLED, tb, lane5); else if (g == 1) pool_item<1>(Z, POOLED, tb, lane5); else if (g == 2) pool_item<2>(Z, POOLED, tb, lane5); else pool_item<3>(Z, POOLED, tb, lane5); } }
#pragma unroll 1
        for (int rd = 0; rd < 3; ++rd) { const int u = F.vcu * 3 + rd; if (u < 768) mx_unit(Z, KVMEM, ABC, u >> 2, u & 3, F.lds, tid5); }
#pragma unroll 1
        for (int rd = 0; rd < 12; ++rd) { const int u = F.vcu * 12 + rd; if (u < 3072) na_unit(Z, rpb, ABC, u >> 3, u & 7, F.lds, tid5); }
        WG_BAR();
    }
    SEAM(5);
    if (IN(6)) {
#ifndef NO_POOLG
        { pg8::Gemm g{POOLED, WPOOLT, NTOK, 1024, 256, 1024, 4 * 32768}; pg8::StaticOrder S; S.init(NTOK, 1024, F.G, (int)blockIdx.x);
          pg8::EpiStoreBlk E{ABC, D, 2048, pool_scale}; pg8::gemm_phase(F.lds, g, S, E); }
#endif
        { pg8::Gemm g{(const bf16*)H8, (const bf16*)W8G, NTOK, 3 * D, D / 2, D / 2, 0}; pg8::XcdOrder S; S.init(NTOK, 3 * D, F.G, (int)blockIdx.x);
          pg8::EpiGateE E{Z + OGATE, ZW, b_gate, 1.f / 64.f}; pg8::gemm_phase<true>(F.lds, g, S, E); }
    }
    SEAM(6);
    if (IN(7)) { pg8::Gemm g{ABC, WCAT, NTOK, D, D, D, 0}; pg8::XcdOrder S; S.init(NTOK, D, F.G, (int)blockIdx.x);
        pg8::EpiChain E{HB, D, Z + OGATE, ZW, 2048 / 64, 3072 / 64}; pg8::gemm_phase(F.lds, g, S, E); }
    SEAM(7);
    if (IN(8)) { pg8::Gemm g{HB, WOT, NTOK, D, D, D, 0}; pg8::XcdOrder S; S.init(NTOK, D, F.G, (int)blockIdx.x);
        pg8::EpiStore E{TB, D, nullptr, 1.f}; pg8::gemm_phase(F.lds, g, S, E); }
    SEAM(8);
    if (IN(9)) { const int lane9 = launder_tid() & 63;
        row_phase<1, true, true>(F, NTOK, NPROMPT, out, out, TB, g_mix_post, 1.0f, nullptr, (float*)X2, nullptr, nullptr, RS3, RS2);
        { TrJob J{w2_gate, WGUT, D, DFF, 1, 0, D, 0, DFF, g_ffn2_pre}; tr_run(J, gw, NGW, lane9, trT); }
        { TrJob J{w2_up, WGUT, D, DFF, 1, 128, D, 0, DFF, g_ffn2_pre}; tr_run(J, gw, NGW, lane9, trT); }
    }
    SEAM(9);
    if (IN(10)) { { pg8::Gemm g{X2, WGUT, NTOK, 2 * DFF, D, D, 0}; pg8::XcdOrder S; S.init(NTOK, 2 * DFF, F.G, (int)blockIdx.x);
          pg8::EpiSwiGLU E{HID, DFF}; pg8::gemm_phase(F.lds, g, S, E); }
        if ((int)blockIdx.x >= 64) { __syncthreads();
            TrJob J{w2_down, WDT, DFF, D, 0, 0, DFF, 0, D}; tr_run(J, ((int)blockIdx.x - 64) * NWAVES + F.wave, (F.G - 64) * NWAVES, launder_tid() & 63, trT); } }
    SEAM(10);
    if (IN(11)) { pg8::Gemm g{HID, WDT, NTOK, D, DFF, DFF, 0}; pg8::XcdOrder S; S.init(NTOK, D, F.G, (int)blockIdx.x, 2);
        pg8::EpiStore E{TB, D, nullptr, 1.f}; pg8::gemm_phase(F.lds, g, S, E); }
    SEAM(11);
    if (IN(12)) row_phase<2, true, false>(F, NTOK, NPROMPT, (const float*)X2, (const float*)X2, TB, g_ffn2_post, 0.5f, g_final, out, nullptr, nullptr, nullptr, RS3);
#undef IN
#undef SEAM
}

extern "C" void kernel_launch(void* const* d_in, const int* in_sizes, int n_in, void* d_out, int out_size, void* d_ws, size_t ws_size, hipStream_t stream) {
    static int grid = 0;
    if (grid == 0) {
        if (n_in != 28 || out_size != NTOK * D || ws_size < WS_END) { fprintf(stderr, "kernel_launch: unexpected shapes (n_in %d, out %d, ws %zu < %zu); nothing launched\n", n_in, out_size, ws_size, (size_t)WS_END); grid = -1; return; }
        int dev = 0, cus = 0, per_cu = 0;
        if (hipGetDevice(&dev) != hipSuccess || hipDeviceGetAttribute(&cus, hipDeviceAttributeMultiprocessorCount, dev) != hipSuccess) { grid = -1; return; }
        if (hipFuncSetAttribute((const void*)mk_fwd, hipFuncAttributeMaxDynamicSharedMemorySize, LDS_BYTES) != hipSuccess) { fprintf(stderr, "kernel_launch: hipFuncSetAttribute failed\n"); grid = -1; return; }
        if (hipOccupancyMaxActiveBlocksPerMultiprocessor(&per_cu, (const void*)mk_fwd, NWAVES * 64, LDS_BYTES) != hipSuccess || per_cu < 1) { fprintf(stderr, "kernel_launch: occupancy query says %d blocks per CU\n", per_cu); }
        (void)hipGetLastError();
        grid = cus;
    }
    if (grid < 0) return;
    if (hipMemsetAsync((char*)d_ws + WS_CTL, 0, CTL_ZERO_BYTES, stream) != hipSuccess) return;
    Args a{};
    for (int i = 0; i < 28; ++i) a.in[i] = (const float*)d_in[i];
    a.out = (float*)d_out; a.ws = (unsigned char*)d_ws;
    if (MK_N_LAUNCHES == 1) { a.ph_lo = 0; a.ph_hi = N_PHASES; hipLaunchKernelGGL(mk_fwd, dim3(grid), dim3(NWAVES * 64), LDS_BYTES, stream, a); }
    else { static const int seq[] = {PROBE_SEQ}; for (unsigned i = 0; i < sizeof(seq) / sizeof(seq[0]); ++i) { a.ph_lo = seq[i]; a.ph_hi = seq[i] + 1; hipLaunchKernelGGL(mk_fwd, dim3(grid), dim3(NWAVES * 64), LDS_BYTES, stream, a); } }
}
```

```cpp
#include <hip/hip_runtime.h>
#include <cstdio>
#include <cstdint>

#ifndef PROBE_SEQ
#define PROBE_SEQ 0,1,2,3,4,5,6,7,8,9,10,11,12
#endif
#ifndef MK_N_LAUNCHES
#define MK_N_LAUNCHES 1
#endif

__device__ __forceinline__ int launder_tid() { int t = threadIdx.x; asm volatile("" : "+v"(t)); return t; }
__host__ __device__ __forceinline__ size_t blk_off(int r, int c, int W) { return ((size_t)(r >> 8) * (size_t)(W >> 6) + (size_t)(c >> 6)) * 32768u + (size_t)((r & 255) * 128 + (c & 63) * 2); }
namespace pg8 {
#define PG8_LAS __attribute__((address_space(3)))
typedef unsigned short bf16_t;
typedef short bf16x8 __attribute__((ext_vector_type(8)));
typedef float f32x4 __attribute__((ext_vector_type(4)));
typedef unsigned u32x4 __attribute__((ext_vector_type(4)));
constexpr int BM = 256, BK = 64, HALF = 128, HTB = HALF * BK * 2  , STAGE_BYTES = 8 * HTB, NXCD = 8, WGM = 8;

__host__ __device__ __forceinline__ int lds_byte(int r, int c) { const int st = (r >> 4) * 2 + (c >> 5), rr = r & 15, cc = c & 31, ob = rr * 64 + cc * 2; return st * 1024 + (ob ^ (((ob >> 9) & 1) << 5)); }
__host__ __device__ __forceinline__ void stage_rc(int b, int& R, int& C) { const int st = b / 1024, sb = b % 1024, swz = sb ^ (((sb >> 9) & 1) << 5); R = (st >> 1) * 16 + swz / 64; C = (st & 1) * 32 + (swz % 64) / 2; }
__host__ __device__ __forceinline__ int perm32(int rho) { const int n = rho >> 4, i = rho & 15; return 8 * (i >> 2) + 4 * n + (i & 3); }
__host__ __device__ __forceinline__ int invperm32(int c) { return ((c >> 2) & 1) * 16 + (c >> 3) * 4 + (c & 3); }

struct Unit { int pm, pn; };
struct Gemm { const bf16_t* A; const bf16_t* Bt; int M, N, K, lda, a_pn_bytes; };

struct StaticOrder {
    int nM, nN, nwg, G, c, wgm;
    __host__ __device__ void init(int M, int N, int G_, int c_, int wgm_ = WGM) { nM = M / BM; nN = N / BM; nwg = nM * nN; G = G_; c = c_; wgm = wgm_; }
    __host__ __device__ bool next(int i, Unit& u) const {
        const long L = (long)i * G + c; if (L >= nwg || c < 0) return false;
        int wgid = (int)L; { const int q = nwg / NXCD, r = nwg % NXCD, xcd = wgid % NXCD, off = wgid / NXCD; wgid = (xcd < r ? xcd * (q + 1) : r * (q + 1) + (xcd - r) * q) + off; }
        const int nig = wgm * nN, gid = wgid / nig, fm = gid * wgm, gsz = (nM - fm) < wgm ? (nM - fm) : wgm;
        u.pm = fm + ((wgid % nig) % gsz); u.pn = (wgid % nig) / gsz; return true;
    }
    __device__ __forceinline__ void a_ready(const Unit&) const {}
    __device__ __forceinline__ void done(const Unit&) const {}
};

struct XcdOrder {
    int nN, c, G; StaticOrder fb; bool use;
    __host__ __device__ void init(int M, int N, int G_, int c_, int wgm_ = WGM) { nN = N / BM; c = c_; G = G_; use = (G_ == 256 && M / BM == 96); fb.init(M, N, G_, c_, wgm_); }
    __host__ __device__ bool next(int i, Unit& u) const {
        if (!use) return fb.next(i, u);
        const int x = c & 7, idx = 32 * i + (c >> 3), nA = 8 * nN;
        if (idx < nA) { u.pm = 12 * x + (idx & 7); u.pn = idx >> 3; return true; }
        const int i2 = idx - nA; if (i2 < 4 * nN) { u.pm = 12 * x + 8 + (i2 & 3); u.pn = i2 >> 2; return true; }
        return false;
    }
    __device__ __forceinline__ void a_ready(const Unit&) const {}
    __device__ __forceinline__ void done(const Unit&) const {}
};
__device__ __forceinline__ unsigned cvt_pk_bf16(float lo, float hi) { unsigned r; asm volatile("v_cvt_pk_bf16_f32 %0, %1, %2" : "=v"(r) : "v"(lo), "v"(hi)); return r; }
__device__ __forceinline__ float bf_lo(unsigned w) { return __uint_as_float(w << 16); }
__device__ __forceinline__ float bf_hi(unsigned w) { return __uint_as_float(w & 0xffff0000u); }

struct EpiStore {
    static constexpr bool PERM = false, HAS_MID = false; static constexpr int NSTORE = 16;
    bf16_t* O; int ldc; const float* colscale; float alpha;
    __device__ __forceinline__ void operator()(const f32x4 (&acc)[2][2][4][2], const Unit& u, int wr, int wc, int fr, int fq) const {
        const int row0 = u.pm * BM + wr * 64 + fr, col0 = u.pn * BM + wc * 32 + 8 * fq;
        f32x4 sc[2][2];
#pragma unroll
        for (int bj = 0; bj < 2; ++bj)
#pragma unroll
            for (int n = 0; n < 2; ++n) sc[bj][n] = colscale ? *(const f32x4*)(colscale + col0 + bj * HALF + 4 * n) * alpha : (f32x4){alpha, alpha, alpha, alpha};
#pragma unroll
        for (int ai = 0; ai < 2; ++ai)
#pragma unroll
            for (int m = 0; m < 4; ++m) { bf16_t* rowp = O + (size_t)(row0 + ai * HALF + m * 16) * ldc + col0;
#pragma unroll
                for (int bj = 0; bj < 2; ++bj) { const f32x4 v0 = acc[ai][bj][m][0] * sc[bj][0], v1 = acc[ai][bj][m][1] * sc[bj][1];
                    u32x4 w; w.x = cvt_pk_bf16(v0[0], v0[1]); w.y = cvt_pk_bf16(v0[2], v0[3]); w.z = cvt_pk_bf16(v1[0], v1[1]); w.w = cvt_pk_bf16(v1[2], v1[3]);
                    *(u32x4*)(rowp + bj * HALF) = w; } }
    }
};
struct EpiStoreBlk {
    static constexpr bool PERM = false, HAS_MID = false; static constexpr int NSTORE = 16;
    bf16_t* O; int W, coff; const float* colscale;
    __device__ __forceinline__ void operator()(const f32x4 (&acc)[2][2][4][2], const Unit& u, int wr, int wc, int fr, int fq) const {
        const int row0 = u.pm * BM + wr * 64 + fr, col0 = u.pn * BM + wc * 32 + 8 * fq;
        f32x4 sc[2][2];
#pragma unroll
        for (int bj = 0; bj < 2; ++bj)
#pragma unroll
            for (int n = 0; n < 2; ++n) sc[bj][n] = colscale ? *(const f32x4*)(colscale + col0 + bj * HALF + 4 * n) : (f32x4){1.f, 1.f, 1.f, 1.f};
#pragma unroll
        for (int ai = 0; ai < 2; ++ai)
#pragma unroll
            for (int m = 0; m < 4; ++m)
#pragma unroll
                for (int bj = 0; bj < 2; ++bj) { const f32x4 v0 = acc[ai][bj][m][0] * sc[bj][0], v1 = acc[ai][bj][m][1] * sc[bj][1];
                    u32x4 w; w.x = cvt_pk_bf16(v0[0], v0[1]); w.y = cvt_pk_bf16(v0[2], v0[3]); w.z = cvt_pk_bf16(v1[0], v1[1]); w.w = cvt_pk_bf16(v1[2], v1[3]);
                    *(u32x4*)((char*)O + blk_off(row0 + ai * HALF + m * 16, coff + col0 + bj * HALF, W)) = w; }
    }
};
struct EpiSwiGLU {
    static constexpr bool PERM = false, HAS_MID = false; static constexpr int NSTORE = 8;
    bf16_t* H; int ldc;
    __device__ __forceinline__ void operator()(const f32x4 (&acc)[2][2][4][2], const Unit& u, int wr, int wc, int fr, int fq) const {
        const int row0 = u.pm * BM + wr * 64 + fr, col0 = u.pn * HALF + wc * 32 + 8 * fq;
#pragma unroll
        for (int ai = 0; ai < 2; ++ai)
#pragma unroll
            for (int m = 0; m < 4; ++m) { bf16_t* rowp = (bf16_t*)((char*)H + blk_off(row0 + ai * HALF + m * 16, col0, ldc)); float o[8];
#pragma unroll
                for (int n = 0; n < 2; ++n)
#pragma unroll
                    for (int j = 0; j < 4; ++j) { const float g = acc[ai][0][m][n][j], up = acc[ai][1][m][n][j];
                        const float sg = __builtin_amdgcn_rcpf(1.0f + __builtin_amdgcn_exp2f(-1.44269504089f * g)); o[4 * n + j] = g * sg * up; }
                u32x4 w; w.x = cvt_pk_bf16(o[0], o[1]); w.y = cvt_pk_bf16(o[2], o[3]); w.z = cvt_pk_bf16(o[4], o[5]); w.w = cvt_pk_bf16(o[6], o[7]);
                *(u32x4*)rowp = w; }
    }
};
struct EpiGateE {
    static constexpr bool PERM = false, HAS_MID = false; static constexpr int NSTORE = 16;
    bf16_t* O; int ldc; const float* bias; float alpha;
    __device__ __forceinline__ void operator()(const f32x4 (&acc)[2][2][4][2], const Unit& u, int wr, int wc, int fr, int fq) const {
        const int row0 = u.pm * BM + wr * 64 + fr, col0 = u.pn * BM + wc * 32 + 8 * fq;
        f32x4 bv[2][2];
#pragma unroll
        for (int bj = 0; bj < 2; ++bj)
#pragma unroll
            for (int n = 0; n < 2; ++n) bv[bj][n] = *(const f32x4*)(bias + col0 + bj * HALF + 4 * n);
#pragma unroll
        for (int ai = 0; ai < 2; ++ai)
#pragma unroll
            for (int m = 0; m < 4; ++m) { bf16_t* rowp = O + (size_t)(row0 + ai * HALF + m * 16) * ldc + col0;
#pragma unroll
                for (int bj = 0; bj < 2; ++bj) { float o[8];
#pragma unroll
                    for (int n = 0; n < 2; ++n)
#pragma unroll
                        for (int j = 0; j < 4; ++j) { const float l = fminf(fmaxf(acc[ai][bj][m][n][j] * alpha + bv[bj][n][j], -30.f), 30.f); o[4 * n + j] = 1.0f + __builtin_amdgcn_exp2f(-1.44269504089f * l); }
                    u32x4 w; w.x = cvt_pk_bf16(o[0], o[1]); w.y = cvt_pk_bf16(o[2], o[3]); w.z = cvt_pk_bf16(o[4], o[5]); w.w = cvt_pk_bf16(o[6], o[7]);
                    *(u32x4*)(rowp + bj * HALF) = w; } }
    }
};
struct EpiChain {
    static constexpr bool PERM = false, HAS_MID = true; static constexpr int NSTORE = 16;
    bf16_t* O; int ldc; const bf16_t* G; int ldg; int mid0, mid1;
    __device__ __forceinline__ void mid(f32x4 (&acc)[2][2][4][2], const Unit& u, int wr, int wc, int fr, int fq, int which) const {
        const int row0 = u.pm * BM + wr * 64 + fr, col0 = u.pn * BM + wc * 32 + 8 * fq;
        const bf16_t* gbase = G + (size_t)row0 * ldg + which * 4096 + col0;
#pragma unroll
        for (int bj = 0; bj < 2; ++bj)
#pragma unroll
            for (int ai = 0; ai < 2; ++ai) {
                u32x4 gd[4], gn[4];
#pragma unroll
                for (int m = 0; m < 4; ++m) { const bf16_t* gp = gbase + (size_t)(ai * HALF + m * 16) * ldg + bj * HALF; gd[m] = *(const u32x4*)gp; gn[m] = *(const u32x4*)(gp + 4096); }
#pragma unroll
                for (int m = 0; m < 4; ++m)
#pragma unroll
                    for (int j = 0; j < 4; ++j) { const int n = j >> 1, e = (j & 1) * 2;
                        const float d0 = bf_lo(gd[m][j]), d1 = bf_hi(gd[m][j]), r = __builtin_amdgcn_rcpf(d0 * d1);
                        acc[ai][bj][m][n][e] *= bf_lo(gn[m][j]) * (r * d1); acc[ai][bj][m][n][e + 1] *= bf_hi(gn[m][j]) * (r * d0); }
                asm volatile("" ::: "memory");
            }
    }
    __device__ __forceinline__ void operator()(const f32x4 (&acc)[2][2][4][2], const Unit& u, int wr, int wc, int fr, int fq) const {
        const int row0 = u.pm * BM + wr * 64 + fr, col0 = u.pn * BM + wc * 32 + 8 * fq;
#pragma unroll
        for (int ai = 0; ai < 2; ++ai)
#pragma unroll
            for (int m = 0; m < 4; ++m) { const size_t r = (size_t)(row0 + ai * HALF + m * 16); const bf16_t* gp = G + r * ldg + 2 * 4096 + col0;
#pragma unroll
                for (int bj = 0; bj < 2; ++bj) { const u32x4 gw = *(const u32x4*)(gp + bj * HALF); float o[8];
#pragma unroll
                    for (int j = 0; j < 4; ++j) { const int n = j >> 1, e = (j & 1) * 2;
                        const float d0 = bf_lo(gw[j]), d1 = bf_hi(gw[j]), rr = __builtin_amdgcn_rcpf(d0 * d1);
                        o[2 * j] = (rr * d1) * acc[ai][bj][m][n][e]; o[2 * j + 1] = (rr * d0) * acc[ai][bj][m][n][e + 1]; }
                    u32x4 w; w.x = cvt_pk_bf16(o[0], o[1]); w.y = cvt_pk_bf16(o[2], o[3]); w.z = cvt_pk_bf16(o[4], o[5]); w.w = cvt_pk_bf16(o[6], o[7]);
                    *(u32x4*)((char*)O + blk_off((int)r, col0 + bj * HALF, ldc)) = w; } }
    }
};

typedef int i32x8 __attribute__((ext_vector_type(8)));
typedef int i32x4_t __attribute__((ext_vector_type(4)));
template <bool FP8 = false, class Epi, class Sched>
__device__ __forceinline__ void gemm_phase(PG8_LAS unsigned char* lds, const Gemm g, const Sched& S, const Epi& E) {
    const int tid = launder_tid(), wid = __builtin_amdgcn_readfirstlane(tid >> 6), lane = tid & 63, wr = wid >> 2, wc = wid & 3, fr = lane & 15, fq = lane >> 4;
    const int K = g.K, nt = K / BK;
    unsigned voffA[2], voffB[2];
#pragma unroll
    for (int i = 0; i < 2; ++i) { int R, C; stage_rc(tid * 16 + i * 8192, R, C); const int Rb = Epi::PERM ? ((R & ~31) + perm32(R & 31)) : R;
        voffA[i] = (unsigned)(R * 64 + C) * 2u; voffB[i] = (unsigned)(Rb * 64 + C) * 2u; }
    const size_t kstep = 32768;
    const size_t hstepA = 16384, hstepB = 16384;
    const size_t tstepA = (size_t)g.lda * 512, tstepB = (size_t)K * 512;
    const unsigned ldsw = (unsigned)wid * 1024u;
    const int aoff = lds_byte(wr * 64 + fr, fq * 8), boff = lds_byte(wc * 32 + fr, fq * 8);
    const PG8_LAS unsigned char* ldsB = lds + 4 * HTB + boff;
#define PG8_SA(b, h) (((b) * 2 + (h)) * HTB)
#define PG8_SB(b, h) ((4 + (b) * 2 + (h)) * HTB)
#define PG8_STAGE(bufoff, gbase, voff) do { _Pragma("unroll") for (int _i = 0; _i < 2; ++_i) \
        __builtin_amdgcn_global_load_lds((const unsigned*)((const char*)(gbase) + (voff)[_i]), (PG8_LAS unsigned*)(lds + (bufoff) + ldsw + _i * 8192), 16, 0, 0); } while (0)
#define PG8_LDA(dst, b, h) do { _Pragma("unroll") for (int m = 0; m < 4; ++m) _Pragma("unroll") for (int k = 0; k < 2; ++k) dst[m][k] = *(const PG8_LAS bf16x8*)(lds + PG8_SA(b, h) + aoff + m * 2048 + k * 1024); } while (0)
#define PG8_LDB(dst, b, h) do { _Pragma("unroll") for (int n = 0; n < 2; ++n) _Pragma("unroll") for (int k = 0; k < 2; ++k) dst[n][k] = *(const PG8_LAS bf16x8*)(ldsB + (PG8_SB(b, h) - 4 * HTB) + n * 2048 + k * 1024); } while (0)
#define PG8_CAT(x) __builtin_shufflevector(__builtin_bit_cast(i32x4_t, (x)[0]), __builtin_bit_cast(i32x4_t, (x)[1]), 0, 1, 2, 3, 4, 5, 6, 7)
#define PG8_MMA(ai, bj, At, Bt) do { __builtin_amdgcn_s_setprio(1); _Pragma("unroll") for (int m = 0; m < 4; ++m) _Pragma("unroll") for (int n = 0; n < 2; ++n) { \
        if constexpr (FP8) acc[ai][bj][m][n] = __builtin_amdgcn_mfma_scale_f32_16x16x128_f8f6f4(PG8_CAT(Bt[n]), PG8_CAT(At[m]), acc[ai][bj][m][n], 0, 0, 0, 0, 0, 0); \
        else { _Pragma("unroll") for (int k = 0; k < 2; ++k) acc[ai][bj][m][n] = __builtin_amdgcn_mfma_f32_16x16x32_bf16(Bt[n][k], At[m][k], acc[ai][bj][m][n], 0, 0, 0); } } \
        __builtin_amdgcn_s_setprio(0); } while (0)
#define PG8_WAIT_V(n) asm volatile("s_waitcnt vmcnt(" #n ")" ::: "memory")
#define PG8_WAIT_VN(n) asm volatile("s_waitcnt vmcnt(%0)" :: "n"(n) : "memory")
#define PG8_WAIT_L(n) asm volatile("s_waitcnt lgkmcnt(" #n ")" ::: "memory")
#define PG8_BAR __builtin_amdgcn_s_barrier()
#define PG8_SCHED __builtin_amdgcn_sched_barrier(0)
    Unit cur, nxt; int ui = 0;
    if (!S.next(0, cur)) return;
    f32x4 acc[2][2][4][2];
#pragma unroll
    for (int a = 0; a < 2; ++a)
#pragma unroll
        for (int b = 0; b < 2; ++b)
#pragma unroll
            for (int m = 0; m < 4; ++m)
#pragma unroll
                for (int n = 0; n < 2; ++n) acc[a][b][m][n] = (f32x4){0.f, 0.f, 0.f, 0.f};
    bf16x8 At[4][2], B0[2][2], B1[2][2];
    const char* cA = (const char*)g.A + (size_t)cur.pm * tstepA + (size_t)cur.pn * g.a_pn_bytes; const char* cB = (const char*)g.Bt + (size_t)cur.pn * tstepB;
    S.a_ready(cur);
    PG8_STAGE(PG8_SB(0, 0), cB, voffB); PG8_STAGE(PG8_SB(0, 1), cB + hstepB, voffB); PG8_STAGE(PG8_SA(0, 0), cA, voffA); PG8_STAGE(PG8_SA(0, 1), cA + hstepA, voffA);
    if (wr == 1) PG8_BAR;
    PG8_WAIT_V(2); PG8_BAR;
    PG8_STAGE(PG8_SB(1, 0), cB + kstep, voffB); PG8_STAGE(PG8_SA(1, 0), cA + kstep, voffA); PG8_STAGE(PG8_SB(1, 1), cB + hstepB + kstep, voffB);
    PG8_WAIT_V(6); PG8_BAR;
    for (;;) {
        const bool has_next = S.next(ui + 1, nxt);
        const char* nA = has_next ? (const char*)g.A + (size_t)nxt.pm * tstepA + (size_t)nxt.pn * g.a_pn_bytes : cA; const char* nB = has_next ? (const char*)g.Bt + (size_t)nxt.pn * tstepB : cB;
        for (int t = 0; t < nt; t += 2) {
            const bool last = (t == nt - 2);
            const char* a1 = cA + (size_t)(t + 1) * kstep;
            const char* a2 = last ? nA : cA + (size_t)(t + 2) * kstep; const char* b2 = last ? nB : cB + (size_t)(t + 2) * kstep;
            const char* a3 = a2 + kstep; const char* b3 = b2 + kstep;
            if (last && has_next) S.a_ready(nxt);
            const bool relax = (ui > 0) && (t == 0);
            PG8_LDB(B0, 0, 0); PG8_LDB(B1, 0, 1); PG8_SCHED; PG8_LDA(At, 0, 0); PG8_STAGE(PG8_SA(1, 1), a1 + hstepA, voffA);
            if (relax) PG8_WAIT_VN(8 + Epi::NSTORE); else PG8_WAIT_V(8);
            PG8_WAIT_L(0); PG8_BAR; PG8_MMA(0, 0, At, B0); PG8_MMA(0, 1, At, B1); PG8_BAR; PG8_SCHED;
            PG8_LDA(At, 0, 1); PG8_STAGE(PG8_SB(0, 0), b2, voffB); PG8_STAGE(PG8_SB(0, 1), b2 + hstepB, voffB); PG8_STAGE(PG8_SA(0, 0), a2, voffA);
            if (relax) PG8_WAIT_VN(8 + Epi::NSTORE); else PG8_WAIT_V(8);
            PG8_WAIT_L(0); PG8_BAR; PG8_MMA(1, 0, At, B0); PG8_MMA(1, 1, At, B1); PG8_BAR; PG8_SCHED;
            PG8_LDB(B0, 1, 0); PG8_LDB(B1, 1, 1); PG8_SCHED; PG8_LDA(At, 1, 0); PG8_STAGE(PG8_SA(0, 1), a2 + hstepA, voffA);
            PG8_WAIT_V(8); PG8_WAIT_L(0); PG8_BAR; PG8_MMA(0, 0, At, B0); PG8_MMA(0, 1, At, B1); PG8_BAR; PG8_SCHED;
            PG8_LDA(At, 1, 1); PG8_STAGE(PG8_SB(1, 0), b3, voffB); PG8_STAGE(PG8_SB(1, 1), b3 + hstepB, voffB); PG8_STAGE(PG8_SA(1, 0), a3, voffA);
            PG8_WAIT_V(8); PG8_WAIT_L(0); PG8_BAR; PG8_MMA(1, 0, At, B0); PG8_MMA(1, 1, At, B1); PG8_BAR; PG8_SCHED;
            if constexpr (Epi::HAS_MID) { const int tn = t + 2; if (tn == E.mid0 || tn == E.mid1) { E.mid(acc, cur, wr, wc, fr, fq, tn == E.mid1 ? 1 : 0); PG8_SCHED; } }
        }
        if (wr == 0) PG8_BAR;
        E(acc, cur, wr, wc, fr, fq); S.done(cur);
        if (!has_next) break;
#pragma unroll
        for (int a = 0; a < 2; ++a)
#pragma unroll
            for (int b = 0; b < 2; ++b)
#pragma unroll
                for (int m = 0; m < 4; ++m)
#pragma unroll
                    for (int n = 0; n < 2; ++n) acc[a][b][m][n] = (f32x4){0.f, 0.f, 0.f, 0.f};
        cur = nxt; cA = nA; cB = nB; ++ui;
        if (wr == 1) PG8_BAR;
    }
    PG8_WAIT_V(0);
    PG8_BAR;
#undef PG8_SA
#undef PG8_SB
#undef PG8_STAGE
#undef PG8_LDA
#undef PG8_LDB
#undef PG8_MMA
#undef PG8_CAT
#undef PG8_WAIT_V
#undef PG8_WAIT_VN
#undef PG8_WAIT_L
#undef PG8_BAR
#undef PG8_SCHED
}
}

constexpr int NWAVES = 8;
constexpr int D = 4096, DFF = 11008, NTOK = 24576, NPROMPT = 16384, ZW = 20480;
constexpr int OQ = 0, OKA = 2048, OVA = 4096, OU = 6144, OQC = 7168, OGATE = 8192;
constexpr int NMEMROW = 768, KVW = 2048;
constexpr float RMS_EPS = 1e-6f;
constexpr int N_PHASES = 13;

constexpr size_t MiB = 1u << 20;
constexpr size_t WS_CTL = 0, CTL_ZERO_BYTES = 1 * MiB;
constexpr size_t WS_MEMN = 1 * MiB;
constexpr size_t WS_KVMEM = 7 * MiB;
constexpr size_t WS_WPOOL = 10 * MiB;
constexpr size_t WS_WMEMKV = 11 * MiB;
constexpr size_t WS_WA = 27 * MiB;
constexpr size_t WS_WB = 43 * MiB;
constexpr size_t WS_WC = 51 * MiB;
constexpr size_t WS_WO = 59 * MiB;
constexpr size_t WS_WIN = 91 * MiB;
constexpr size_t WS_WGU = 251 * MiB;
constexpr size_t WS_WD = 423 * MiB;
constexpr size_t WS_POOLED = 251 * MiB;
constexpr size_t WS_H8 = 299 * MiB;
constexpr size_t WS_W8G = 395 * MiB;
constexpr size_t WS_H = 509 * MiB;
constexpr size_t WS_T = 701 * MiB;
constexpr size_t WS_ABUF = 701 * MiB, WS_BBUF = 797 * MiB, WS_CBUF = 845 * MiB;
constexpr size_t WS_BIG = 893 * MiB;
constexpr size_t WS_END = 1853 * MiB;
constexpr int CW_TMO = 0, CW_BAR = 4096;

constexpr int RING_BYTES = 131072, LDSCTL_OFF = RING_BYTES, MISC_OFF = LDSCTL_OFF + 320, LDS_BYTES = 147456;

#define GAS __attribute__((address_space(1)))
#define LAS __attribute__((address_space(3)))
typedef unsigned short bf16;
typedef unsigned v4u __attribute__((ext_vector_type(4)));
typedef unsigned v2u __attribute__((ext_vector_type(2)));
typedef float f32x4 __attribute__((ext_vector_type(4)));
typedef short bf16x8 __attribute__((ext_vector_type(8)));
typedef short s16x4 __attribute__((ext_vector_type(4)));
typedef GAS unsigned gu32;
#define RLX_AGENT __ATOMIC_RELAXED, __HIP_MEMORY_SCOPE_AGENT
#define LDS_WAIT() asm volatile("s_waitcnt lgkmcnt(0)" ::: "memory")
#define VM_WAIT() asm volatile("s_waitcnt vmcnt(0)" ::: "memory")
__device__ __forceinline__ unsigned pk2(float lo, float hi) { return pg8::cvt_pk_bf16(lo, hi); }
using pg8::bf_lo; using pg8::bf_hi;

#define XB_TMO      128
#define XB_XCNT(j)  (256  + 64 * (j))
#define XB_XSUB(j)  (1280 + 64 * (j))
#define XB_XGEN(j)  (2304 + 64 * (j))
#define XB_TOP      3328
#define XB_TOPGEN   3392
#define XCD_BAR_WORDS 3456
#define XB_SPIN_CAP (1u << 18)

__device__ __forceinline__ unsigned xb_ld(unsigned* p)              { return __hip_atomic_load(p, __ATOMIC_RELAXED, __HIP_MEMORY_SCOPE_AGENT); }
__device__ __forceinline__ unsigned xb_add(unsigned* p, unsigned v) { return __hip_atomic_fetch_add(p, v, __ATOMIC_RELAXED, __HIP_MEMORY_SCOPE_AGENT); }
__device__ __forceinline__ unsigned xb_xcc_id() { return (unsigned)__builtin_amdgcn_s_getreg((3 << 11) | 20) & 0xFu; }
#define XB_SPIN(cond, bar) do { unsigned _sp = 0; while (cond) { __builtin_amdgcn_s_sleep(1); \
    if ((++_sp & 255u) == 0u) { if (xb_ld(&(bar)[XB_TMO])) break; if (_sp > XB_SPIN_CAP) { atomicAdd(&(bar)[XB_TMO], 1u); break; } } } } while (0)

struct XcdBarrier { unsigned* bar; unsigned x; volatile LAS unsigned* st; };

__device__ __forceinline__ XcdBarrier xcd_barrier_post(unsigned* bar, volatile LAS unsigned* st) {
    XcdBarrier b; b.bar = bar; b.x = xb_xcc_id(); b.st = st;
    if (threadIdx.x == 0) (void)xb_add(&bar[XB_XCNT(b.x)], 1u);
    return b;
}
__device__ __forceinline__ void xcd_barrier_complete(unsigned* bar, unsigned x, unsigned& nloc, unsigned& nx) {
    const unsigned G = gridDim.x * gridDim.y * gridDim.z;
    unsigned sum, cnt, mine, sp = 0u;
    for (;;) {
        sum = 0u; cnt = 0u; mine = 0u;
#pragma unroll
        for (unsigned j = 0; j < 16; ++j) { const unsigned c = xb_ld(&bar[XB_XCNT(j)]); sum += c; cnt += (c > 0u) ? 1u : 0u; mine = (j == x) ? c : mine; }
        if (sum == G) break;
        __builtin_amdgcn_s_sleep(1);
        if ((++sp & 255u) == 0u) { if (xb_ld(&bar[XB_TMO])) break; if (sp > XB_SPIN_CAP) { atomicAdd(&bar[XB_TMO], 1u); break; } }
    }
    nloc = mine > 0u ? mine : 1u; nx = cnt > 0u ? cnt : 1u;
}
__device__ __forceinline__ void xcd_barrier(const XcdBarrier& b) {
    asm volatile("s_waitcnt vmcnt(0)" ::: "memory");
    __syncthreads();
    if (threadIdx.x == 0) {
        unsigned* bar = b.bar;
        __builtin_amdgcn_s_waitcnt(0);
        unsigned nloc = b.st[0], nx = b.st[1];
        if (nloc == 0u) { xcd_barrier_complete(bar, b.x, nloc, nx); b.st[0] = nloc; b.st[1] = nx; }
        const unsigned old = xb_add(&bar[XB_XSUB(b.x)], 1u);
        const unsigned gen = old / nloc;
        if (old + 1u == (gen + 1u) * nloc) {
            __builtin_amdgcn_fence(__ATOMIC_RELEASE, "agent");
            asm volatile("s_waitcnt vmcnt(0)" ::: "memory");
            const unsigned og = xb_add(&bar[XB_TOP], 1u);
            const unsigned tg = og / nx;
            if (og + 1u == (tg + 1u) * nx) xb_add(&bar[XB_TOPGEN], 1u);
            else XB_SPIN(xb_ld(&bar[XB_TOPGEN]) == tg, bar);
            __builtin_amdgcn_fence(__ATOMIC_ACQUIRE, "agent");
            xb_add(&bar[XB_XGEN(b.x)], 1u);
            asm volatile("s_waitcnt vmcnt(0)" ::: "memory");
        } else {
            XB_SPIN(xb_ld(&bar[XB_XGEN(b.x)]) == gen, bar);
            __builtin_amdgcn_fence(__ATOMIC_ACQUIRE, "agent");
            asm volatile("s_waitcnt vmcnt(0)" ::: "memory");
        }
    }
    __syncthreads();
}

struct Frame {
    LAS unsigned char* lds;
    int tid, lane, wave;
    int vcu, G;
};

__device__ __forceinline__ float wave_sum(float v) {
#pragma unroll
    for (int o = 1; o < 64; o <<= 1) v += __shfl_xor(v, o);
    return v;
}

struct TrJob { const float* W; bf16* WT; int K, N, sh, roff, ldo, koff, ncv; const float* kscale; };
__device__ __forceinline__ void tr_load(const TrJob& J, int it, int lane, f32x4 (&v)[8]) {
    const int nblk = J.ncv >> 5, kb = it / nblk, nb = it - kb * nblk;
    const float* src = J.W + (size_t)(kb * 64 + 2 * (lane >> 3)) * J.N + nb * 32 + 4 * (lane & 7);
#pragma unroll
    for (int i = 0; i < 8; ++i) v[i] = __builtin_nontemporal_load((const GAS f32x4*)(src + (size_t)(16 * (i >> 1) + (i & 1)) * J.N));
    if (J.kscale) {
#pragma unroll
        for (int i = 0; i < 8; ++i) v[i] = v[i] * J.kscale[kb * 64 + 2 * (lane >> 3) + 16 * (i >> 1) + (i & 1)];
    }
}
__device__ __forceinline__ void tr_store(const TrJob& J, int it, int lane, const f32x4 (&v)[8], LAS unsigned* T) {
    const int nblk = J.ncv >> 5, kb = it / nblk, nb = it - kb * nblk;
#pragma unroll
    for (int ip = 0; ip < 4; ++ip)
#pragma unroll
        for (int j = 0; j < 4; ++j) T[(4 * (lane & 7) + j) * 33 + 8 * ip + (lane >> 3)] = pk2(v[2 * ip][j], v[2 * ip + 1][j]);
    LDS_WAIT(); asm volatile("" ::: "memory");
#pragma unroll
    for (int jp = 0; jp < 4; ++jp) { const int nl = 8 * jp + (lane >> 3), c = lane & 7; const LAS unsigned* s = T + nl * 33 + 4 * c;
        v4u o; o.x = s[0]; o.y = s[1]; o.z = s[2]; o.w = s[3];
        const int n = nb * 32 + nl; const int orow0 = ((n >> 7) << (7 + J.sh)) + (n & 127) + J.roff, orow = (orow0 & ~31) + pg8::invperm32(orow0 & 31);
        *(GAS v4u*)((GAS char*)J.WT + blk_off(orow, J.koff + kb * 64 + 8 * c, J.ldo)) = o; }
    LDS_WAIT(); asm volatile("" ::: "memory");
}
__device__ __forceinline__ void tr_run(const TrJob& J, int w0, int nw, int lane, LAS unsigned* T) {
    const int nitems = (J.K >> 6) * (J.ncv >> 5);
    f32x4 va[8], vb[8];
    int it = w0;
    if (it < nitems) tr_load(J, it, lane, va);
    while (it < nitems) {
        const int it2 = it + nw;
        if (it2 < nitems) tr_load(J, it2, lane, vb);
        tr_store(J, it, lane, va, T);
        if (it2 >= nitems) break;
        const int it3 = it2 + nw;
        if (it3 < nitems) tr_load(J, it3, lane, va);
        tr_store(J, it2, lane, vb, T);
        it = it3;
    }
}

__device__ __forceinline__ size_t blk8_off(int r, int k, int Kb) { return ((size_t)(r >> 8) * (size_t)(Kb >> 7) + (size_t)(k >> 7)) * 32768u + (size_t)((r & 255) * 128 + (k & 127)); }
__device__ __forceinline__ unsigned pk4_fp8(float a, float b, float c, float d) { int w = __builtin_amdgcn_cvt_pk_fp8_f32(a, b, 0, false); w = __builtin_amdgcn_cvt_pk_fp8_f32(c, d, w, true); return (unsigned)w; }
__device__ __forceinline__ void w8_load(const float* W, int N, int c0, int nnb, int it, int lane, float (&v)[16], const float* kscale) {
    const int kc = it / nnb, nb = it - kc * nnb; const float* src = W + (size_t)(kc * 16) * N + c0 + nb * 64 + lane;
#pragma unroll
    for (int i = 0; i < 16; ++i) v[i] = __builtin_nontemporal_load((const GAS float*)(src + (size_t)i * N)) * kscale[kc * 16 + i];
}
__device__ __forceinline__ void w8_store(unsigned char* W8, int K, int nnb, int it, int lane, float scale, const float (&v)[16]) {
    const int kc = it / nnb, nb = it - kc * nnb, n = nb * 64 + lane, k0 = kc * 16;
    v4u o; o.x = pk4_fp8(v[0] * scale, v[1] * scale, v[2] * scale, v[3] * scale); o.y = pk4_fp8(v[4] * scale, v[5] * scale, v[6] * scale, v[7] * scale);
    o.z = pk4_fp8(v[8] * scale, v[9] * scale, v[10] * scale, v[11] * scale); o.w = pk4_fp8(v[12] * scale, v[13] * scale, v[14] * scale, v[15] * scale);
    *(GAS v4u*)((GAS unsigned char*)W8 + blk8_off((n & ~31) + pg8::invperm32(n & 31), k0, K)) = o;
}
__device__ __forceinline__ void w8_run(const float* W, unsigned char* W8, int K, int N, int c0, int ncv, float scale, int w0, int nw, int lane, const float* kscale) {
    const int nnb = ncv >> 6, nitems = (K >> 4) * nnb;
    float va[16], vb[16], vc[16];
    int it = w0;
    if (it < nitems) w8_load(W, N, c0, nnb, it, lane, va, kscale);
    if (it + nw < nitems) w8_load(W, N, c0, nnb, it + nw, lane, vb, kscale);
    while (it < nitems) {
        if (it + 2 * nw < nitems) w8_load(W, N, c0, nnb, it + 2 * nw, lane, vc, kscale);
        w8_store(W8, K, nnb, it, lane, scale, va);
        if (it + nw >= nitems) break;
        if (it + 3 * nw < nitems) w8_load(W, N, c0, nnb, it + 3 * nw, lane, va, kscale);
        w8_store(W8, K, nnb, it + nw, lane, scale, vb);
        if (it + 2 * nw >= nitems) break;
        if (it + 4 * nw < nitems) w8_load(W, N, c0, nnb, it + 4 * nw, lane, vb, kscale);
        w8_store(W8, K, nnb, it + 2 * nw, lane, scale, vc);
        it += 3 * nw;
    }
}

template <int MODE, bool XIN16 = false, bool FOLD = false>
__device__ __forceinline__ void row_phase(const Frame& F, int nrows, int split, const float* xa, const float* xb, const bf16* t, const float* g_post, float alpha, const float* g_next, float* xout, bf16* hout, unsigned char* h8out = nullptr, float* rsout = nullptr, const float* rsin = nullptr) {
    const int gw = F.vcu * NWAVES + F.wave, NGW = F.G * NWAVES, tid = launder_tid(), lane = tid & 63;
    const unsigned o16 = (unsigned)lane * 16u, o8 = (unsigned)lane * 8u;
    __syncthreads();
    for (int i = tid; i < D / 4; i += NWAVES * 64) { if (MODE != 0) ((LAS f32x4*)F.lds)[i] = ((const GAS f32x4*)g_post)[i]; if (!FOLD) ((LAS f32x4*)(F.lds + 16384))[i] = ((const GAS f32x4*)g_next)[i]; }
    __syncthreads();
    const LAS unsigned char* lgp = F.lds + o16; const LAS unsigned char* lgn = F.lds + 16384 + o16;
#define RP_F4(base, j) (*(const GAS f32x4*)((const GAS char*)(base) + (o16 + (unsigned)(j) * 1024u)))
#define RP_H4(base, j) (*(const GAS v2u*)((const GAS char*)(base) + (o8 + (unsigned)(j) * 512u)))
    const unsigned hoff0 = (unsigned)(lane >> 4) * 32768u + (unsigned)(lane & 15) * 8u;
    const unsigned h8off0 = (unsigned)(lane >> 5) * 32768u + (unsigned)(lane & 31) * 4u;
    for (int row = gw; row < nrows; row += NGW) {
        asm volatile("" ::: "memory");
        unsigned hoff = hoff0, h8off = h8off0; asm volatile("" : "+v"(hoff), "+v"(h8off));
        const float* xr = (row < split) ? xa + (size_t)row * D : xb + (size_t)(row - split) * D;
        const size_t rblk = (size_t)(row >> 8) * 64 * 32768 + (size_t)(row & 255) * 128;
        f32x4 x[16];
        if (XIN16) { const GAS char* xb16 = (const GAS char*)xa + rblk; const float ri = rsin[row];
#pragma unroll
            for (int j = 0; j < 16; ++j) { const v2u w = *(const GAS v2u*)(xb16 + (hoff + (unsigned)j * 131072u)); x[j] = (f32x4){bf_lo(w.x) * ri, bf_hi(w.x) * ri, bf_lo(w.y) * ri, bf_hi(w.y) * ri}; } }
        else {
#pragma unroll
            for (int j = 0; j < 16; ++j) x[j] = RP_F4(xr, j); }
        if (MODE != 0) {
            const bf16* tr = t + (size_t)row * D;
            v2u tv[16]; float ss = 0.f;
#pragma unroll
            for (int j = 0; j < 16; ++j) tv[j] = RP_H4(tr, j);
#pragma unroll
            for (int j = 0; j < 16; ++j) { const float a = bf_lo(tv[j].x), b = bf_hi(tv[j].x), c = bf_lo(tv[j].y), d = bf_hi(tv[j].y); ss += (a * a + b * b) + (c * c + d * d); }
            const float rs = alpha * __builtin_amdgcn_rsqf(wave_sum(ss) * (1.f / D) + RMS_EPS);
#pragma unroll
            for (int j = 0; j < 16; ++j) { const f32x4 gp = *(const LAS f32x4*)(lgp + j * 1024);
                x[j].x += rs * bf_lo(tv[j].x) * gp.x; x[j].y += rs * bf_hi(tv[j].x) * gp.y; x[j].z += rs * bf_lo(tv[j].y) * gp.z; x[j].w += rs * bf_hi(tv[j].y) * gp.w; }
        }
        float s2 = 0.f;
#pragma unroll
        for (int j = 0; j < 16; ++j) s2 += (x[j].x * x[j].x + x[j].y * x[j].y) + (x[j].z * x[j].z + x[j].w * x[j].w);
        const float ms = wave_sum(s2) * (1.f / D) + RMS_EPS, r2 = __builtin_amdgcn_rsqf(ms);
        const GAS char* h8 = (const GAS char*)h8out + ((size_t)(row >> 8) * 32 * 32768 + (size_t)(row & 255) * 128);
        if (FOLD) {
            if (lane == 0) rsout[row] = ms * r2;
            const GAS char* xob = (const GAS char*)xout + rblk;
#pragma unroll
            for (int j = 0; j < 16; ++j) { const f32x4 y = (f32x4){x[j].x * r2, x[j].y * r2, x[j].z * r2, x[j].w * r2};
                v2u o; o.x = pk2(y.x, y.y); o.y = pk2(y.z, y.w); *(GAS v2u*)((GAS char*)xob + (hoff + (unsigned)j * 131072u)) = o;
                if (h8out) *(GAS unsigned*)((GAS char*)h8 + (h8off + (unsigned)j * 65536u)) = pk4_fp8(y.x, y.y, y.z, y.w); }
        } else {
            float* xo2 = xout + (size_t)row * D;
            const GAS char* ho = (const GAS char*)hout + rblk;
#pragma unroll
            for (int j = 0; j < 16; ++j) { const f32x4 gn = *(const LAS f32x4*)(lgn + j * 1024);
                const f32x4 y = (f32x4){x[j].x * r2 * gn.x, x[j].y * r2 * gn.y, x[j].z * r2 * gn.z, x[j].w * r2 * gn.w};
                if (MODE == 2) __builtin_nontemporal_store(y, (GAS f32x4*)((GAS char*)xo2 + (o16 + (unsigned)j * 1024u)));
                else { v2u o; o.x = pk2(y.x, y.y); o.y = pk2(y.z, y.w); *(GAS v2u*)((GAS char*)ho + (hoff + (unsigned)j * 131072u)) = o; } }
        }
    }
#undef RP_F4
#undef RP_H4
    __syncthreads();
}

__device__ __forceinline__ bf16x8 pack_p(const f32x4 a, const f32x4 b) {
    const unsigned w0 = pk2(a[0], a[1]), w1 = pk2(a[2], a[3]), w2 = pk2(b[0], b[1]), w3 = pk2(b[2], b[3]);
    v4u w = (v4u){w0, w1, w2, w3}; return __builtin_bit_cast(bf16x8, w);
}
#define MEMFENCE() asm volatile("" ::: "memory")
#define WG_BAR() do { asm volatile("s_waitcnt lgkmcnt(0)" ::: "memory"); __builtin_amdgcn_s_barrier(); asm volatile("" ::: "memory"); } while (0)
constexpr int NA_KP = 272, NA_VP = 288, NA_KBUF = 2 * 64 * NA_KP, NA_VBUF = 2 * 64 * NA_VP;
constexpr int MX_KP = 528, MX_VP = 544, MX_KBUF = 64 * MX_KP, MX_VBUF = 32 * MX_VP;
constexpr int ATT_BIAS_OFF = 2 * NA_VBUF;
static_assert(2 * NA_KBUF <= ATT_BIAS_OFF && 2 * MX_KBUF <= ATT_BIAS_OFF && 2 * MX_VBUF <= ATT_BIAS_OFF && ATT_BIAS_OFF + 8 * 2048 <= RING_BYTES, "attention LDS map");

__device__ __forceinline__ void na_unit(const bf16* z, const float* rpb, bf16* Aout, int R, int hp, LAS unsigned char* lds, int tid) {
    const int lane = tid & 63, wave = __builtin_amdgcn_readfirstlane(tid >> 6), hl = wave >> 2, qg = wave & 3, h = 2 * hp + hl;
    const int q = lane & 15, kq = lane >> 4;
    int seq0, rows; if (R < 256) { seq0 = 0; rows = 256; } else if (R < 320) { seq0 = 256; rows = 64; } else { seq0 = 320; rows = 64; }
    const int r = R - seq0; int rs = r - 4; rs = rs < 0 ? 0 : (rs > rows - 8 ? rows - 8 : rs);
    const int krow0 = seq0 + rs, c0 = 16 * qg, cb = (qg == 0) ? 0 : (qg == 1) ? 8 : (qg == 2) ? 24 : 32;
    LAS float* bl = (LAS float*)(lds + ATT_BIAS_OFF + wave * 2048);
#pragma unroll
    for (int k = 0; k < 4; ++k) { const int idx = lane + 64 * k, i = idx >> 5, co = idx & 31; if (co < 31) bl[i * 64 + 16 + co] = rpb[h * 465 + (rs + i - r + 7) * 31 + co]; }
    bf16x8 qf[4]; { const bf16* qp = z + (size_t)(R * 64 + c0 + q) * ZW + OQ + h * 128 + 8 * kq;
#pragma unroll
        for (int ks = 0; ks < 4; ++ks) qf[ks] = *(const GAS bf16x8*)(qp + 32 * ks); }
    const int skey = tid >> 5, sch = tid & 31;
    const bf16* ksrc = z + (size_t)(krow0 * 64 + skey) * ZW + OKA + hp * 256 + 8 * sch;
    const int kdst = (sch >> 4) * (64 * NA_KP) + skey * NA_KP + (sch & 15) * 16, vdst = (sch >> 4) * (64 * NA_VP) + skey * NA_VP + (sch & 15) * 16;
#define NA_LD(dst, src, i) do { _Pragma("unroll") for (int v = 0; v < 4; ++v) dst[v] = *(const GAS v4u*)((src) + (size_t)((i) * 64 + 16 * v) * ZW); } while (0)
#define NA_ST(srcr, off, pitch) do { _Pragma("unroll") for (int v = 0; v < 4; ++v) *(LAS v4u*)(lds + (off) + v * 16 * (pitch)) = srcr[v]; } while (0)
    v4u ra[4], rb[4], rc[4];
    NA_LD(ra, ksrc, 0); NA_LD(rb, ksrc, 1); NA_LD(rc, ksrc, 2);
    f32x4 S[8][2];
    const int kfo = hl * (64 * NA_KP) + (cb + q) * NA_KP + kq * 16;
    WG_BAR();
#define NA_QK(i, b) do { const LAS unsigned char* kb_ = lds + (b) * NA_KBUF + kfo; _Pragma("unroll") for (int hf = 0; hf < 2; ++hf) { f32x4 a_ = (f32x4){0.f, 0.f, 0.f, 0.f}; \
        _Pragma("unroll") for (int ks = 0; ks < 4; ++ks) a_ = __builtin_amdgcn_mfma_f32_16x16x32_bf16(*(const LAS bf16x8*)(kb_ + hf * 16 * NA_KP + ks * 64), qf[ks], a_, 0, 0, 0); S[i][hf] = a_; } } while (0)
#define NA_KSTEP(i, reg) do { NA_ST(reg, ((i) & 1) * NA_KBUF + kdst, NA_KP); if ((i) + 3 < 8) NA_LD(reg, ksrc, (i) + 3); else NA_LD(reg, ksrc + (OVA - OKA), (i) + 3 - 8); WG_BAR(); NA_QK(i, (i) & 1); } while (0)
    NA_KSTEP(0, ra); NA_KSTEP(1, rb); NA_KSTEP(2, rc); NA_KSTEP(3, ra); NA_KSTEP(4, rb); NA_KSTEP(5, rc); NA_KSTEP(6, ra); NA_KSTEP(7, rb);
    const int c = c0 + q; int cs = c - 8; cs = cs < 0 ? 0 : (cs > 48 ? 48 : cs);
    const float scale = 0.08838834764831845f, NEG = -1e30f;
    float mx = NEG;
#pragma unroll
    for (int i = 0; i < 8; ++i)
#pragma unroll
        for (int hf = 0; hf < 2; ++hf)
#pragma unroll
            for (int e = 0; e < 4; ++e) { const int col = cb + 16 * hf + 4 * kq + e; const bool ok = (unsigned)(col - cs) < 16u;
                const float b = bl[i * 64 + 16 + (col - c + 15)];
                const float s_ = ok ? (S[i][hf][e] * scale + b) : NEG; S[i][hf][e] = s_; mx = fmaxf(mx, s_); }
    mx = fmaxf(mx, __shfl_xor(mx, 16)); mx = fmaxf(mx, __shfl_xor(mx, 32));
    float l = 0.f;
#pragma unroll
    for (int i = 0; i < 8; ++i)
#pragma unroll
        for (int hf = 0; hf < 2; ++hf)
#pragma unroll
            for (int e = 0; e < 4; ++e) { const float p = __builtin_amdgcn_exp2f((S[i][hf][e] - mx) * 1.44269504089f); S[i][hf][e] = p; l += p; }
    l += __shfl_xor(l, 16); l += __shfl_xor(l, 32);
    f32x4 O[8];
#pragma unroll
    for (int db = 0; db < 8; ++db) O[db] = (f32x4){0.f, 0.f, 0.f, 0.f};
    const int vfo = hl * (64 * NA_VP) + (cb + 4 * kq + ((lane & 15) >> 2)) * NA_VP + 8 * (lane & 3);
    const bf16* vsrc = ksrc + (OVA - OKA);
    WG_BAR();
#define NA_PV(i, b) do { const LAS unsigned char* r0_ = lds + (b) * NA_VBUF + vfo; const bf16x8 pf_ = pack_p(S[i][0], S[i][1]); _Pragma("unroll") for (int db = 0; db < 8; ++db) { \
        const s16x4 lo_ = __builtin_amdgcn_ds_read_tr16_b64_v4i16((LAS s16x4*)(r0_ + 32 * db)), hi_ = __builtin_amdgcn_ds_read_tr16_b64_v4i16((LAS s16x4*)(r0_ + 16 * NA_VP + 32 * db)); \
        O[db] = __builtin_amdgcn_mfma_f32_16x16x32_bf16((bf16x8){lo_[0], lo_[1], lo_[2], lo_[3], hi_[0], hi_[1], hi_[2], hi_[3]}, pf_, O[db], 0, 0, 0); } } while (0)
#define NA_VSTEP(i, reg) do { NA_ST(reg, ((i) & 1) * NA_VBUF + vdst, NA_VP); if ((i) + 3 < 8) NA_LD(reg, vsrc, (i) + 3); WG_BAR(); NA_PV(i, (i) & 1); } while (0)
    NA_VSTEP(0, rc); NA_VSTEP(1, ra); NA_VSTEP(2, rb); NA_VSTEP(3, rc); NA_VSTEP(4, ra); NA_VSTEP(5, rb); NA_VSTEP(6, rc); NA_VSTEP(7, ra);
#undef NA_LD
#undef NA_ST
#undef NA_QK
#undef NA_KSTEP
#undef NA_PV
#undef NA_VSTEP
    const float inv = 1.0f / l;
#pragma unroll
    for (int db = 0; db < 8; ++db) { v2u o; o.x = pk2(O[db][0] * inv, O[db][1] * inv); o.y = pk2(O[db][2] * inv, O[db][3] * inv);
        *(GAS v2u*)((GAS char*)Aout + blk_off(R * 64 + c0 + q, h * 128 + 16 * db + 4 * kq, D)) = o; }
}

__device__ __forceinline__ void mx_unit(const bf16* z, const bf16* kvmem, bf16* Cout, int tb2, int hc, LAS unsigned char* lds, int tid) {
    const int lane = tid & 63, wave = __builtin_amdgcn_readfirstlane(tid >> 6), q = lane & 15, kq = lane >> 4, tok0 = 128 * tb2 + 16 * wave;
    const int bq = tb2 < (NPROMPT >> 7) ? 0 : 1 + ((tb2 - (NPROMPT >> 7)) >> 5);
    const bf16* kv = kvmem + (size_t)bq * 256 * KVW;
    const int skey = tid >> 5, sch = tid & 31;
    const bf16* ksrc = kv + (size_t)skey * KVW + hc * 256 + 8 * sch;
    const bf16* vsrc = ksrc + 1024;
    const int kdst = skey * MX_KP + sch * 16, vdst = skey * MX_VP + sch * 16;
    bf16x8 pf[8]; float l;
    {
        bf16x8 qf[8]; { const bf16* qp = z + (size_t)(tok0 + q) * ZW + OQC + hc * 256 + 8 * kq;
#pragma unroll
            for (int ks = 0; ks < 8; ++ks) qf[ks] = *(const GAS bf16x8*)(qp + 32 * ks); }
        v4u ra[4], rb[4], rc[4];
#define MX_KLD(dst, j) do { _Pragma("unroll") for (int v = 0; v < 4; ++v) dst[v] = *(const GAS v4u*)(ksrc + (size_t)(64 * (j) + 16 * v) * KVW); } while (0)
#define MX_KST(srcr, b) do { _Pragma("unroll") for (int v = 0; v < 4; ++v) *(LAS v4u*)(lds + (b) * MX_KBUF + kdst + v * 16 * MX_KP) = srcr[v]; } while (0)
        MX_KLD(ra, 0); MX_KLD(rb, 1); MX_KLD(rc, 2);
        f32x4 S[16];
        const int kfo = q * MX_KP + kq * 16;
        WG_BAR();
#define MX_QK(j, b) do { _Pragma("unroll") for (int t = 0; t < 4; ++t) { const LAS unsigned char* kb_ = lds + (b) * MX_KBUF + kfo + t * 16 * MX_KP; f32x4 a_ = (f32x4){0.f, 0.f, 0.f, 0.f}; \
        _Pragma("unroll") for (int ks = 0; ks < 8; ++ks) a_ = __builtin_amdgcn_mfma_f32_16x16x32_bf16(*(const LAS bf16x8*)(kb_ + ks * 64), qf[ks], a_, 0, 0, 0); S[4 * (j) + t] = a_; } } while (0)
        MX_KST(ra, 0); MX_KLD(ra, 3); WG_BAR(); MX_QK(0, 0);
        MX_KST(rb, 1); WG_BAR(); MX_QK(1, 1);
        MX_KST(rc, 0); WG_BAR(); MX_QK(2, 0);
        MX_KST(ra, 1); WG_BAR(); MX_QK(3, 1);
#undef MX_KLD
#undef MX_KST
#undef MX_QK
        float mx = -1e30f;
#pragma unroll
        for (int kt = 0; kt < 16; ++kt)
#pragma unroll
            for (int e = 0; e < 4; ++e) mx = fmaxf(mx, S[kt][e]);
        mx = fmaxf(mx, __shfl_xor(mx, 16)); mx = fmaxf(mx, __shfl_xor(mx, 32));
        l = 0.f; const float sc = 0.0625f * 1.44269504089f;
#pragma unroll
        for (int kt = 0; kt < 16; ++kt)
#pragma unroll
            for (int e = 0; e < 4; ++e) { const float p = __builtin_amdgcn_exp2f((S[kt][e] - mx) * sc); S[kt][e] = p; l += p; }
        l += __shfl_xor(l, 16); l += __shfl_xor(l, 32);
#pragma unroll
        for (int kb = 0; kb < 8; ++kb) pf[kb] = pack_p(S[2 * kb], S[2 * kb + 1]);
    }
    const float inv = 1.0f / l;
    v4u va[2], vb[2], vc[2];
#define MX_VLD(dst, s_) do { _Pragma("unroll") for (int v = 0; v < 2; ++v) dst[v] = *(const GAS v4u*)(vsrc + (size_t)(32 * (s_) + 16 * v) * KVW); } while (0)
#define MX_VST(srcr, b) do { _Pragma("unroll") for (int v = 0; v < 2; ++v) *(LAS v4u*)(lds + (b) * MX_VBUF + vdst + v * 16 * MX_VP) = srcr[v]; } while (0)
    MX_VLD(va, 0); MX_VLD(vb, 1); MX_VLD(vc, 2);
    f32x4 O[16];
#pragma unroll
    for (int db = 0; db < 16; ++db) O[db] = (f32x4){0.f, 0.f, 0.f, 0.f};
    const int vfo = (4 * kq + ((lane & 15) >> 2)) * MX_VP + 8 * (lane & 3);
    WG_BAR();
#define MX_PV(s_, b) do { const LAS unsigned char* r0_ = lds + (b) * MX_VBUF + vfo; _Pragma("unroll") for (int db = 0; db < 16; ++db) { \
        const s16x4 lo_ = __builtin_amdgcn_ds_read_tr16_b64_v4i16((LAS s16x4*)(r0_ + 32 * db)), hi_ = __builtin_amdgcn_ds_read_tr16_b64_v4i16((LAS s16x4*)(r0_ + 16 * MX_VP + 32 * db)); \
        O[db] = __builtin_amdgcn_mfma_f32_16x16x32_bf16((bf16x8){lo_[0], lo_[1], lo_[2], lo_[3], hi_[0], hi_[1], hi_[2], hi_[3]}, pf[s_], O[db], 0, 0, 0); } } while (0)
#define MX_VSTEP(s_, reg) do { MX_VST(reg, (s_) & 1); if ((s_) + 3 < 8) MX_VLD(reg, (s_) + 3); WG_BAR(); MX_PV(s_, (s_) & 1); } while (0)
    MX_VSTEP(0, va); MX_VSTEP(1, vb); MX_VSTEP(2, vc); MX_VSTEP(3, va); MX_VSTEP(4, vb); MX_VSTEP(5, vc); MX_VSTEP(6, va); MX_VSTEP(7, vb);
#undef MX_VLD
#undef MX_VST
#undef MX_PV
#undef MX_VSTEP
#pragma unroll
    for (int db = 0; db < 16; ++db) { v2u o; o.x = pk2(O[db][0] * inv, O[db][1] * inv); o.y = pk2(O[db][2] * inv, O[db][3] * inv);
        *(GAS v2u*)((GAS char*)Cout + blk_off(tok0 + q, 3072 + hc * 256 + 16 * db + 4 * kq, D)) = o; }
}

template <int G> __device__ __forceinline__ void pool_item(const bf16* z, bf16* pooled, int tb, int lane) {
    constexpr int HW = 1 << G, NR = 16 + 2 * HW;
    const int t0g = 16 * tb; int sbase, L; if (t0g < NPROMPT) { sbase = 0; L = NPROMPT; } else { sbase = NPROMPT + (((t0g - NPROMPT) >> 12) << 12); L = 4096; }
    const int t0 = t0g - sbase;
    f32x4 rv[NR];
#pragma unroll
    for (int k = 0; k < NR; ++k) { const int s = t0 - HW + k; const bool ok = (s >= 0) && (s < L); const int sc = ok ? s : t0;
        const v2u w = *(const GAS v2u*)(z + (size_t)(sbase + sc) * ZW + OU + 256 * G + 4 * lane);
        rv[k] = ok ? (f32x4){bf_lo(w.x), bf_hi(w.x), bf_lo(w.y), bf_hi(w.y)} : (f32x4){0.f, 0.f, 0.f, 0.f}; }
    f32x4 win = (f32x4){0.f, 0.f, 0.f, 0.f};
#pragma unroll
    for (int k = 0; k < 2 * HW; ++k) win += rv[k];
#pragma unroll
    for (int j = 0; j < 16; ++j) { const int t = t0 + j; const int lo = (t - HW) < 0 ? 0 : (t - HW), hi = (t + HW) > L ? L : (t + HW);
        const float ic = 1.0f / (float)(hi - lo); const f32x4 pz = win * ic - rv[j + HW];
        v2u o; o.x = pk2(pz.x, pz.y); o.y = pk2(pz.z, pz.w);
        *(GAS v2u*)((GAS char*)pooled + blk_off(t0g + j, 256 * G + 4 * lane, 1024)) = o;
        if (j < 15) win += rv[j + 2 * HW] - rv[j]; }
}

struct Args { const float* in[28]; float* out; unsigned char* ws; int ph_lo, ph_hi; };
__global__ void __launch_bounds__(NWAVES * 64, 2) mk_fwd(Args args) {
    extern __shared__ __attribute__((aligned(16))) unsigned char lds[];
    Frame F;
    F.lds = (LAS unsigned char*)lds;
    F.tid = threadIdx.x; F.lane = F.tid & 63; F.wave = __builtin_amdgcn_readfirstlane(F.tid >> 6);
    F.G = gridDim.x; { const int bx = blockIdx.x; F.vcu = (F.G % 8 == 0) ? (bx % 8) * (F.G / 8) + bx / 8 : bx; }
    unsigned char* ws = args.ws;
    gu32* ctl = (gu32*)(ws + WS_CTL);
    for (int u = F.tid; u < (LDS_BYTES - LDSCTL_OFF) / 4; u += NWAVES * 64) ((LAS unsigned*)(F.lds + LDSCTL_OFF))[u] = 0u;
    __syncthreads();
    XcdBarrier bar; bar.bar = (unsigned*)(ctl + CW_BAR); bar.x = 0; bar.st = nullptr;
    if (MK_N_LAUNCHES == 1) bar = xcd_barrier_post((unsigned*)(ctl + CW_BAR), (volatile LAS unsigned*)(F.lds + MISC_OFF) + 8);
    const int lo = args.ph_lo, hi = args.ph_hi;
#ifndef PH_MASK
#define PH_MASK 0x1fff
#endif
#define IN(k) (((PH_MASK >> (k)) & 1) && lo <= (k) && (k) < hi)
#define SEAM(k) do { if (IN(k) && IN((k) + 1)) xcd_barrier(bar); } while (0)

    const float* x_prompt = args.in[0]; const float* x_sample = args.in[1]; const float* mem_prompt = args.in[2]; const float* mem_sample = args.in[3];
    const float* g_ffn1_pre = args.in[4]; const float* w1_gate = args.in[5]; const float* w1_up = args.in[6]; const float* w1_down = args.in[7]; const float* g_ffn1_post = args.in[8];
    const float* g_mix_pre = args.in[9]; const float* w_in = args.in[10]; const float* rpb = args.in[11]; const float* w_pool = args.in[12]; const float* pool_scale = args.in[13];
    const float* g_mem = args.in[14]; const float* w_mem_kv = args.in[15]; const float* w_a_out = args.in[16]; const float* w_b_out = args.in[17]; const float* w_c_out = args.in[18];
    const float* b_gate = args.in[19]; const float* w_o = args.in[20]; const float* g_mix_post = args.in[21]; const float* g_ffn2_pre = args.in[22];
    const float* w2_gate = args.in[23]; const float* w2_up = args.in[24]; const float* w2_down = args.in[25]; const float* g_ffn2_post = args.in[26]; const float* g_final = args.in[27];
    float* out = args.out;
    bf16* MEMN = (bf16*)(ws + WS_MEMN); bf16* KVMEM = (bf16*)(ws + WS_KVMEM); bf16* WPOOLT = (bf16*)(ws + WS_WPOOL); bf16* WMEMKVT = (bf16*)(ws + WS_WMEMKV);
    bf16* WCAT = (bf16*)(ws + WS_WA); bf16* WOT = (bf16*)(ws + WS_WO); bf16* WINT = (bf16*)(ws + WS_WIN);
    bf16* WGUT = (bf16*)(ws + WS_WGU); bf16* WDT = (bf16*)(ws + WS_WD); bf16* POOLED = (bf16*)(ws + WS_POOLED);
    float* RS2 = (float*)(ws + WS_CTL + 128 * 1024); float* RS3 = (float*)(ws + WS_CTL + 256 * 1024);
    unsigned char* H8 = ws + WS_H8; unsigned char* W8G = ws + WS_W8G; bf16* HB = (bf16*)(ws + WS_H); bf16* TB = (bf16*)(ws + WS_T); bf16* ABC = (bf16*)(ws + WS_T);
    bf16* HID = (bf16*)(ws + WS_BIG); bf16* Z = (bf16*)(ws + WS_BIG); bf16* X2 = (bf16*)(ws + WS_BIG + 600 * MiB);
    const int gw = F.vcu * NWAVES + F.wave, NGW = F.G * NWAVES;
    LAS unsigned* trT = (LAS unsigned*)(F.lds + F.wave * 4352);

    if (IN(0)) {
        const int lane0 = launder_tid() & 63;
        row_phase<0>(F, NTOK, NPROMPT, x_prompt, x_sample, nullptr, nullptr, 0.f, g_ffn1_pre, nullptr, HB);
        row_phase<0>(F, NMEMROW, 256, mem_prompt, mem_sample, nullptr, nullptr, 0.f, g_mem, nullptr, MEMN);
        { TrJob J{w1_gate, WGUT, D, DFF, 1, 0, D, 0, DFF}; tr_run(J, gw, NGW, lane0, trT); }
        { TrJob J{w1_up, WGUT, D, DFF, 1, 128, D, 0, DFF}; tr_run(J, gw, NGW, lane0, trT); }
        { TrJob J{w_mem_kv, WMEMKVT, D, KVW, 0, 0, D, 0, KVW}; tr_run(J, gw, NGW, lane0, trT); }
        { TrJob J{w1_down, WDT, DFF, D, 0, 0, DFF, 0, D}; tr_run(J, gw, NGW, lane0, trT); }
    }
    SEAM(0);
    if (IN(1)) {
        { pg8::Gemm g{HB, WGUT, NTOK, 2 * DFF, D, D, 0}; pg8::XcdOrder S; S.init(NTOK, 2 * DFF, F.G, (int)blockIdx.x);
          pg8::EpiSwiGLU E{HID, DFF}; pg8::gemm_phase(F.lds, g, S, E); }
        { const int c2 = (int)blockIdx.x - 64;
          pg8::Gemm g{MEMN, WMEMKVT, NMEMROW, KVW, D, D, 0}; pg8::StaticOrder S; S.init(NMEMROW, KVW, 24, (c2 >= 0 && c2 < 24) ? c2 : -1);
          pg8::EpiStore E{KVMEM, KVW, nullptr, 1.f}; pg8::gemm_phase(F.lds, g, S, E); }
        if ((int)blockIdx.x >= 88) { __syncthreads();
            const int w0 = ((int)blockIdx.x - 88) * NWAVES + F.wave, nw = (F.G - 88) * NWAVES, lane1 = launder_tid() & 63;
            { TrJob J{w_in, WINT, D, ZW, 0, 0, D, 0, OGATE, g_mix_pre}; tr_run(J, w0, nw, lane1, trT); }
            { TrJob J{w_a_out, WCAT, 2048, D, 0, 0, D, 0, D}; tr_run(J, w0, nw, lane1, trT); }
            { TrJob J{w_b_out, WCAT, 1024, D, 0, 0, D, 2048, D}; tr_run(J, w0, nw, lane1, trT); }
            { TrJob J{w_c_out, WCAT, 1024, D, 0, 0, D, 3072, D}; tr_run(J, w0, nw, lane1, trT); }
            { TrJob J{w_o, WOT, D, D, 0, 0, D, 0, D}; tr_run(J, w0, nw, lane1, trT); }
#pragma unroll 1
            for (int g = 0; g < 4; ++g) { TrJob J{w_pool + (size_t)g * 65536, WPOOLT + (size_t)g * 65536, 256, 256, 0, 0, 256, 0, 256}; tr_run(J, w0, nw, lane1, trT); } }
    }
    SEAM(1);
    if (IN(2)) { pg8::Gemm g{HID, WDT, NTOK, D, DFF, DFF, 0}; pg8::XcdOrder S; S.init(NTOK, D, F.G, (int)blockIdx.x, 2);
        pg8::EpiStore E{TB, D, nullptr, 1.f}; pg8::gemm_phase(F.lds, g, S, E); }
    SEAM(2);
    if (IN(3)) { row_phase<1, false, true>(F, NTOK, NPROMPT, x_prompt, x_sample, TB, g_ffn1_post, 0.5f, nullptr, out, nullptr, H8, RS2);
        w8_run(w_in, W8G, D, ZW, OGATE, 3 * D, 64.f, gw, NGW, launder_tid() & 63, g_mix_pre); }
    SEAM(3);
    if (IN(4)) { pg8::Gemm g{(const bf16*)out, WINT, NTOK, OGATE, D, D, 0}; pg8::XcdOrder S; S.init(NTOK, OGATE, F.G, (int)blockIdx.x);
        pg8::EpiStore E{Z, ZW, nullptr, 1.f}; pg8::gemm_phase(F.lds, g, S, E); }
    SEAM(4);
    if (IN(5)) {
        const int tid5 = launder_tid(), lane5 = tid5 & 63;
#pragma unroll 1
        for (int rd = 0; rd < 3; ++rd) { const int item = (F.vcu * 3 + rd) * NWAVES + F.wave; if (item < 6144) {
            const int tb = item >> 2, g = item & 3;
            if (g == 0) pool_item<0>(Z, POOLED, tb, lane5); else if (g == 1) pool_item<1>(Z, POOLED, tb, lane5); else if (g == 2) pool_item<2>(Z, POOLED, tb, lane5); else pool_item<3>(Z, POOLED, tb, lane5); } }
#pragma unroll 1
        for (int rd = 0; rd < 3; ++rd) { const int u = F.vcu * 3 + rd; if (u < 768) mx_unit(Z, KVMEM, ABC, u >> 2, u & 3, F.lds, tid5); }
#pragma unroll 1
        for (int rd = 0; rd < 12; ++rd) { const int u = F.vcu * 12 + rd; if (u < 3072) na_unit(Z, rpb, ABC, u >> 3, u & 7, F.lds, tid5); }
        WG_BAR();
    }
    SEAM(5);
    if (IN(6)) {
#ifndef NO_POOLG
        { pg8::Gemm g{POOLED, WPOOLT, NTOK, 1024, 256, 1024, 4 * 32768}; pg8::StaticOrder S; S.init(NTOK, 1024, F.G, (int)blockIdx.x);
          pg8::EpiStoreBlk E{ABC, D, 2048, pool_scale}; pg8::gemm_phase(F.lds, g, S, E); }
#endif
        { pg8::Gemm g{(const bf16*)H8, (const bf16*)W8G, NTOK, 3 * D, D / 2, D / 2, 0}; pg8::XcdOrder S; S.init(NTOK, 3 * D, F.G, (int)blockIdx.x);
          pg8::EpiGateE E{Z + OGATE, ZW, b_gate, 1.f / 64.f}; pg8::gemm_phase<true>(F.lds, g, S, E); }
    }
    SEAM(6);
    if (IN(7)) { pg8::Gemm g{ABC, WCAT, NTOK, D, D, D, 0}; pg8::XcdOrder S; S.init(NTOK, D, F.G, (int)blockIdx.x);
        pg8::EpiChain E{HB, D, Z + OGATE, ZW, 2048 / 64, 3072 / 64}; pg8::gemm_phase(F.lds, g, S, E); }
    SEAM(7);
    if (IN(8)) { pg8::Gemm g{HB, WOT, NTOK, D, D, D, 0}; pg8::XcdOrder S; S.init(NTOK, D, F.G, (int)blockIdx.x);
        pg8::EpiStore E{TB, D, nullptr, 1.f}; pg8::gemm_phase(F.lds, g, S, E); }
    SEAM(8);
    if (IN(9)) { const int lane9 = launder_tid() & 63;
        row_phase<1, true, true>(F, NTOK, NPROMPT, out, out, TB, g_mix_post, 1.0f, nullptr, (float*)X2, nullptr, nullptr, RS3, RS2);
        { TrJob J{w2_gate, WGUT, D, DFF, 1, 0, D, 0, DFF, g_ffn2_pre}; tr_run(J, gw, NGW, lane9, trT); }
        { TrJob J{w2_up, WGUT, D, DFF, 1, 128, D, 0, DFF, g_ffn2_pre}; tr_run(J, gw, NGW, lane9, trT); }
    }
    SEAM(9);
    if (IN(10)) { { pg8::Gemm g{X2, WGUT, NTOK, 2 * DFF, D, D, 0}; pg8::XcdOrder S; S.init(NTOK, 2 * DFF, F.G, (int)blockIdx.x);
          pg8::EpiSwiGLU E{HID, DFF}; pg8::gemm_phase(F.lds, g, S, E); }
        if ((int)blockIdx.x >= 64) { __syncthreads();
            TrJob J{w2_down, WDT, DFF, D, 0, 0, DFF, 0, D}; tr_run(J, ((int)blockIdx.x - 64) * NWAVES + F.wave, (F.G - 64) * NWAVES, launder_tid() & 63, trT); } }
    SEAM(10);
    if (IN(11)) { pg8::Gemm g{HID, WDT, NTOK, D, DFF, DFF, 0}; pg8::XcdOrder S; S.init(NTOK, D, F.G, (int)blockIdx.x, 2);
        pg8::EpiStore E{TB, D, nullptr, 1.f}; pg8::gemm_phase(F.lds, g, S, E); }
    SEAM(11);
    if (IN(12)) row_phase<2, true, false>(F, NTOK, NPROMPT, (const float*)X2, (const float*)X2, TB, g_ffn2_post, 0.5f, g_final, out, nullptr, nullptr, nullptr, RS3);
#undef IN
#undef SEAM
}

extern "C" void kernel_launch(void* const* d_in, const int* in_sizes, int n_in, void* d_out, int out_size, void* d_ws, size_t ws_size, hipStream_t stream) {
    static int grid = 0;
    if (grid == 0) {
        if (n_in != 28 || out_size != NTOK * D || ws_size < WS_END) { fprintf(stderr, "kernel_launch: unexpected shapes (n_in %d, out %d, ws %zu < %zu); nothing launched\n", n_in, out_size, ws_size, (size_t)WS_END); grid = -1; return; }
        int dev = 0, cus = 0, per_cu = 0;
        if (hipGetDevice(&dev) != hipSuccess || hipDeviceGetAttribute(&cus, hipDeviceAttributeMultiprocessorCount, dev) != hipSuccess) { grid = -1; return; }
        if (hipFuncSetAttribute((const void*)mk_fwd, hipFuncAttributeMaxDynamicSharedMemorySize, LDS_BYTES) != hipSuccess) { fprintf(stderr, "kernel_launch: hipFuncSetAttribute failed\n"); grid = -1; return; }
        if (hipOccupancyMaxActiveBlocksPerMultiprocessor(&per_cu, (const void*)mk_fwd, NWAVES * 64, LDS_BYTES) != hipSuccess || per_cu < 1) { fprintf(stderr, "kernel_launch: occupancy query says %d blocks per CU\n", per_cu); }
        (void)hipGetLastError();
        grid = cus;
    }
    if (grid < 0) return;
    if (hipMemsetAsync((char*)d_ws + WS_CTL, 0, CTL_ZERO_BYTES, stream) != hipSuccess) return;
    Args a{};
    for (int i = 0; i < 28; ++i) a.in[i] = (const float*)d_in[i];
    a.out = (float*)d_out; a.ws = (unsigned char*)d_ws;
    if (MK_N_LAUNCHES == 1) { a.ph_lo = 0; a.ph_hi = N_PHASES; hipLaunchKernelGGL(mk_fwd, dim3(grid), dim3(NWAVES * 64), LDS_BYTES, stream, a); }
    else { static const int seq[] = {PROBE_SEQ}; for (unsigned i = 0; i < sizeof(seq) / sizeof(seq[0]); ++i) { a.ph_lo = seq[i]; a.ph_hi = seq[i] + 1; hipLaunchKernelGGL(mk_fwd, dim3(grid), dim3(NWAVES * 64), LDS_BYTES, stream, a); } }
}
```
